# Optimizing an MI355X kernel written in HIP

```python
import jax, jax.numpy as jnp
from jax import lax
import numpy as np

D_MODEL = 1024
BATCH = 4
SEQ = 8192
DEPTH = 1

HEAD = 64
RW_HEADS = 8
RW_DIM = RW_HEADS * HEAD
FOX_HEADS = 8
FOX_DIM = FOX_HEADS * HEAD
MIX_DIM = RW_DIM + FOX_DIM
DECAY_LORA = 64
AAA_LORA = 64
GATE_LORA = 128
RW_SPLITS = (RW_DIM, DECAY_LORA, RW_DIM, RW_DIM, AAA_LORA, GATE_LORA)
RW_COLS = sum(RW_SPLITS)
FOX_SPLITS = (FOX_DIM, FOX_DIM, FOX_DIM, FOX_HEADS)
FOX_COLS = sum(FOX_SPLITS)
IN_COLS = RW_COLS + FOX_COLS
Q_BLOCK = 128
N_GROUPS = 8
EXPERTS_PER_GROUP = 8
N_EXPERTS = N_GROUPS * EXPERTS_PER_GROUP
TOP_K = 2
D_EXPERT = D_MODEL // 2
ROW_BLOCK = 128
NORM_EPS = 1e-6
GN_EPS = 64e-5

kernel_name = "hymba_rwkv7_fox_hmoe"


def rms_norm(x, w, eps=NORM_EPS):
    xf = x.astype(jnp.float32)
    y = xf * lax.rsqrt(jnp.mean(xf * xf, axis=-1, keepdims=True) + eps)
    return (y * w.astype(jnp.float32)).astype(x.dtype)


def split_cols(p, sizes):
    idx = np.cumsum(sizes)[:-1].tolist()
    return jnp.split(p, idx, axis=-1)


def token_shift(p, mu):
    prev = jnp.pad(p, ((0, 0), (1, 0), (0, 0)))[:, :-1]
    return p + (prev - p) * mu


def rwkv7_scan(r, w, k, v, a, b):
    B_, T_, H_, N_ = r.shape

    def step(S, inp):
        r_t, w_t, k_t, v_t, a_t, b_t = inp
        sa = jnp.einsum('bhvk,bhk->bhv', S, a_t)
        S = S * w_t[:, :, None, :] + sa[..., None] * b_t[:, :, None, :] + v_t[..., None] * k_t[:, :, None, :]
        return S, jnp.einsum('bhvk,bhk->bhv', S, r_t)

    xs = tuple(jnp.moveaxis(z, 1, 0) for z in (r, w, k, v, a, b))
    S0 = jnp.zeros((B_, H_, N_, N_), jnp.float32)
    _, y = lax.scan(step, S0, xs)
    return jnp.moveaxis(y, 0, 1)


def rwkv7_mixer(p_rw, mu, w0, w2, a0, a2, g2, k_k, k_a, r_k, ln_w, ln_b):
    B_, T_, _ = p_rw.shape
    ps = token_shift(p_rw.astype(jnp.float32), mu.astype(jnp.float32))
    r, pw, k, v, pa, pg = split_cols(ps, RW_SPLITS)
    w = -jax.nn.softplus(-(w0 + jnp.tanh(pw) @ w2)) - 0.5
    decay = jnp.exp(-jnp.exp(w))
    a = jax.nn.sigmoid(a0 + pa @ a2)
    g = jax.nn.sigmoid(pg) @ g2
    heads = lambda z: z.reshape(B_, T_, RW_HEADS, HEAD)
    kk = heads(k * k_k)
    kk = kk / jnp.maximum(jnp.sqrt(jnp.sum(kk * kk, axis=-1, keepdims=True)), 1e-12)
    k = k * (1.0 + (a - 1.0) * k_a)
    r_h, k_h, v_h, a_h, w_h = heads(r), heads(k), heads(v), heads(a), heads(decay)
    y = rwkv7_scan(r_h, w_h, k_h, v_h, -kk, kk * a_h)
    mean = jnp.mean(y, axis=-1, keepdims=True)
    var = jnp.mean(jnp.square(y - mean), axis=-1, keepdims=True)
    y = ((y - mean) * lax.rsqrt(var + GN_EPS)).reshape(B_, T_, RW_DIM) * ln_w + ln_b
    bonus = jnp.sum(r_h * k_h * r_k, axis=-1, keepdims=True) * v_h
    return (y + bonus.reshape(B_, T_, RW_DIM)) * g


def fox_attention(q, k, v, log_f):
    T_ = q.shape[1]
    c = jnp.cumsum(log_f, axis=1).transpose(0, 2, 1)
    scale = HEAD ** -0.5
    outs = []
    for blk in range(T_ // Q_BLOCK):
        q0, q1 = blk * Q_BLOCK, (blk + 1) * Q_BLOCK
        s = jnp.einsum('bqhd,bkhd->bhqk', q[:, q0:q1], k[:, :q1]).astype(jnp.float32) * scale
        s = s + c[:, :, q0:q1, None] - c[:, :, None, :q1]
        causal = jnp.arange(q1)[None, :] <= jnp.arange(q0, q1)[:, None]
        s = jnp.where(causal, s, -jnp.inf)
        p = jax.nn.softmax(s, axis=-1)
        outs.append(jnp.einsum('bhqk,bkhd->bqhd', p.astype(v.dtype), v[:, :q1]))
    return jnp.concatenate(outs, axis=1)


def fox_mixer(p_fox, b_f, qn_w, kn_w):
    B_, T_, _ = p_fox.shape
    q, k, v, f = split_cols(p_fox, FOX_SPLITS)
    heads = lambda z: z.reshape(B_, T_, FOX_HEADS, HEAD)
    q = rms_norm(heads(q), qn_w)
    k = rms_norm(heads(k), kn_w)
    log_f = jax.nn.log_sigmoid((f + b_f).astype(jnp.float32))
    return fox_attention(q, k, heads(v), log_f).reshape(B_, T_, FOX_DIM)


def hierarchical_moe(h, rg_w, rg_b, re_w, re_b, w_gate, w_up, w_down):
    B_, T_, D_ = h.shape
    xt = h.reshape(-1, D_)
    M = xt.shape[0]
    g_logits = (xt @ rg_w + rg_b).astype(jnp.float32)
    g_prob = jax.nn.softmax(g_logits, axis=-1)
    g_sel = jnp.argmax(g_logits, axis=-1)
    g_gate = jnp.take_along_axis(g_prob, g_sel[:, None], axis=-1)
    e_logits = (xt @ re_w + re_b).astype(jnp.float32).reshape(M, N_GROUPS, EXPERTS_PER_GROUP)
    e_logits = jnp.take_along_axis(e_logits, g_sel[:, None, None], axis=1)[:, 0]
    top_p, top_i = lax.top_k(jax.nn.softmax(e_logits, axis=-1), TOP_K)
    gates = g_gate * top_p / jnp.sum(top_p, axis=-1, keepdims=True)
    expert_id = (g_sel[:, None] * EXPERTS_PER_GROUP + top_i).astype(jnp.int32)
    A = M * TOP_K
    flat_id = expert_id.reshape(A)
    flat_tok = jnp.repeat(jnp.arange(M, dtype=jnp.int32), TOP_K)
    order = jnp.argsort(flat_id)
    sid = flat_id[order]
    counts = jnp.bincount(flat_id, length=N_EXPERTS)
    start = jnp.cumsum(counts) - counts
    padded = (counts + ROW_BLOCK - 1) // ROW_BLOCK * ROW_BLOCK
    pad_end = jnp.cumsum(padded)
    pad_start = pad_end - padded
    dest_sorted = (pad_start[sid] + jnp.arange(A, dtype=jnp.int32) - start[sid]).astype(jnp.int32)
    n_blocks = (A + N_EXPERTS * (ROW_BLOCK - 1) + ROW_BLOCK - 1) // ROW_BLOCK
    buf_tok = jnp.zeros((n_blocks * ROW_BLOCK,), jnp.int32).at[dest_sorted].set(flat_tok[order])
    block_expert = jnp.minimum(
        jnp.searchsorted(pad_end, jnp.arange(n_blocks, dtype=jnp.int32) * ROW_BLOCK, side='right'),
        N_EXPERTS - 1)
    xb = xt[buf_tok].reshape(n_blocks, ROW_BLOCK, D_)

    def expert_block(args):
        xblk, e = args
        hid = jax.nn.silu(xblk @ w_gate[e]) * (xblk @ w_up[e])
        return hid @ w_down[e]

    yb = lax.map(expert_block, (xb, block_expert)).reshape(-1, D_)
    dest = jnp.zeros((A,), jnp.int32).at[order].set(dest_sorted)
    y = jnp.sum(yb[dest].reshape(M, TOP_K, D_) * gates[..., None].astype(yb.dtype), axis=1)
    return y.reshape(B_, T_, D_)


def setup_inputs(seed: int = 0) -> dict:
    key = jax.random.key(seed)
    ks = jax.random.split(key, 32)
    n = lambda i, shape, s: jax.random.normal(ks[i], shape, jnp.float32) * s
    L = DEPTH
    return {
        "x": n(0, (BATCH, SEQ, D_MODEL), 1.0),
        "norm_mix_w": 1.0 + n(1, (L, D_MODEL), 0.05),
        "w_in": n(2, (L, D_MODEL, IN_COLS), D_MODEL ** -0.5),
        "mu_shift": jax.random.uniform(ks[3], (L, RW_COLS), jnp.float32),
        "rw_w0": jax.random.uniform(ks[4], (L, RW_DIM), jnp.float32, minval=-4.0, maxval=1.0),
        "rw_w2": n(5, (L, DECAY_LORA, RW_DIM), 0.1 * DECAY_LORA ** -0.5),
        "rw_a0": n(6, (L, RW_DIM), 0.1),
        "rw_a2": n(7, (L, AAA_LORA, RW_DIM), AAA_LORA ** -0.5),
        "rw_g2": n(8, (L, GATE_LORA, RW_DIM), GATE_LORA ** -0.5),
        "rw_k_k": 0.85 + n(9, (L, RW_DIM), 0.05),
        "rw_k_a": 1.0 + n(10, (L, RW_DIM), 0.05),
        "rw_r_k": n(11, (L, RW_HEADS, HEAD), 0.1),
        "rw_ln_w": 1.0 + n(12, (L, RW_DIM), 0.05),
        "rw_ln_b": n(13, (L, RW_DIM), 0.02),
        "fox_b_f": jax.random.uniform(ks[14], (L, FOX_HEADS), jnp.float32, minval=1.0, maxval=4.0),
        "fox_q_norm_w": 1.0 + n(15, (L, HEAD), 0.05),
        "fox_k_norm_w": 1.0 + n(16, (L, HEAD), 0.05),
        "w_out": n(17, (L, MIX_DIM, D_MODEL), MIX_DIM ** -0.5),
        "norm_ffn_w": 1.0 + n(18, (L, D_MODEL), 0.05),
        "router_group_w": n(19, (L, D_MODEL, N_GROUPS), D_MODEL ** -0.5),
        "router_group_b": n(20, (L, N_GROUPS), 0.01),
        "router_expert_w": n(21, (L, D_MODEL, N_EXPERTS), D_MODEL ** -0.5),
        "router_expert_b": n(22, (L, N_EXPERTS), 0.01),
        "exp_w_gate": n(23, (L, N_EXPERTS, D_MODEL, D_EXPERT), D_MODEL ** -0.5),
        "exp_w_up": n(24, (L, N_EXPERTS, D_MODEL, D_EXPERT), D_MODEL ** -0.5),
        "exp_w_down": n(25, (L, N_EXPERTS, D_EXPERT, D_MODEL), D_EXPERT ** -0.5),
    }


def reference(x, norm_mix_w, w_in, mu_shift, rw_w0, rw_w2, rw_a0, rw_a2, rw_g2, rw_k_k, rw_k_a,
              rw_r_k, rw_ln_w, rw_ln_b, fox_b_f, fox_q_norm_w, fox_k_norm_w, w_out, norm_ffn_w,
              router_group_w, router_group_b, router_expert_w, router_expert_b,
              exp_w_gate, exp_w_up, exp_w_down):
    for l in range(DEPTH):
        h = rms_norm(x, norm_mix_w[l])
        p = h @ w_in[l]
        y_rw = rwkv7_mixer(p[..., :RW_COLS], mu_shift[l], rw_w0[l], rw_w2[l], rw_a0[l], rw_a2[l],
                           rw_g2[l], rw_k_k[l], rw_k_a[l], rw_r_k[l], rw_ln_w[l], rw_ln_b[l])
        y_fox = fox_mixer(p[..., RW_COLS:], fox_b_f[l], fox_q_norm_w[l], fox_k_norm_w[l])
        y_mix = jnp.concatenate([y_rw.astype(x.dtype), y_fox.astype(x.dtype)], axis=-1)
        x = x + y_mix @ w_out[l]
        h = rms_norm(x, norm_ffn_w[l])
        x = x + hierarchical_moe(h, router_group_w[l], router_group_b[l], router_expert_w[l],
                                 router_expert_b[l], exp_w_gate[l], exp_w_up[l], exp_w_down[l]).astype(x.dtype)
    return x
```

```cpp
#include <hip/hip_runtime.h>
#include <cstdio>
#include <cstdint>

#ifndef MK_N_LAUNCHES
#define MK_N_LAUNCHES 13
#endif

#define GAS __attribute__((address_space(1)))
#define LAS __attribute__((address_space(3)))
typedef unsigned short bf16;
typedef float f32x4 __attribute__((ext_vector_type(4)));
typedef unsigned u32x4 __attribute__((ext_vector_type(4)));
typedef unsigned u32x2 __attribute__((ext_vector_type(2)));

constexpr int BATCH = 4, SEQ = 8192, DM = 1024, M = BATCH * SEQ;
constexpr int RW_COLS = 1792, FOX_COLS = 1544, IN_COLS = 3336;
constexpr int C_R = 0, C_PW = 512, C_K = 576, C_V = 1088, C_PA = 1600, C_PG = 1664;
constexpr int NEXP = 64, DEXP = 512, NSEG = 128;
constexpr float LOG2E = 1.4426950408889634f;
constexpr float QSCALE = 0.125f * LOG2E;
constexpr int NWAVES = 8, NTHREADS = 512;
constexpr int NPHASE = 13;
constexpr int N_LAUNCHES = MK_N_LAUNCHES;
constexpr int LDS_BYTES = 147456;

constexpr size_t MiB = 1u << 20;
constexpr size_t WS_CTL = 0, CTL_ZERO_BYTES = 1 * MiB;
constexpr size_t WS_XN = 16 * MiB;
constexpr size_t WS_QF = 16 * MiB, WS_KF = 48 * MiB;
constexpr size_t WS_LD = 16 * MiB;
constexpr size_t WS_H2 = 16 * MiB;
constexpr size_t WS_YMIX = 80 * MiB;
constexpr size_t WS_LIST = 80 * MiB, WS_LG = 82 * MiB;
constexpr size_t WS_PRW = 144 * MiB;
constexpr size_t WS_HID = 144 * MiB;
constexpr size_t WS_PFOX = 256 * MiB;
constexpr size_t WS_K2 = 256 * MiB, WS_KK = 288 * MiB, WS_BB = 320 * MiB;
constexpr size_t WS_VF = 353 * MiB;
constexpr size_t WS_G = 353 * MiB;
constexpr size_t WS_LOGF = 385 * MiB, WS_CUMF = 386 * MiB;
constexpr size_t WS_EID = 387 * MiB;
constexpr size_t WS_GATE = WS_EID + 256 * 1024, WS_RANK = WS_GATE + 256 * 1024;
constexpr size_t WS_Y = 388 * MiB;
constexpr size_t WS_END = 452 * MiB;
constexpr int CW_CNT = 64;
constexpr int CW_BAR = 4096;

struct Params {
    const float* in[26];
    float* out;
    unsigned char* ws;
    int ph_lo, ph_hi, li, pad;
};
#define CAS __attribute__((address_space(4)))
typedef CAS Params CParams;
__device__ __forceinline__ const CParams* kp_launder(const CParams* q) { asm volatile("" : "+s"(q)); return q; }

__device__ __forceinline__ float bf2f(unsigned u) { return __uint_as_float(u << 16); }
__device__ __forceinline__ unsigned f2bf(float f) { unsigned u = __float_as_uint(f); return (u + 0x7fffu + ((u >> 16) & 1u)) >> 16; }
__device__ __forceinline__ unsigned pk2(float lo, float hi) { return f2bf(lo) | (f2bf(hi) << 16); }
__device__ __forceinline__ float wave_sum(float v) {
#pragma unroll
    for (int o = 1; o < 64; o <<= 1) v += __shfl_xor(v, o);
    return v;
}
__device__ __forceinline__ float sigmoidf_(float x) { return 1.0f / (1.0f + __expf(-x)); }
__device__ __forceinline__ float softplusf_(float z) { return fmaxf(z, 0.f) + log1pf(__expf(-fabsf(z))); }

#define XB_TMO      128
#define XB_XCNT(j)  (256  + 64 * (j))
#define XB_XSUB(j)  (1280 + 64 * (j))
#define XB_XGEN(j)  (2304 + 64 * (j))
#define XB_TOP      3328
#define XB_TOPGEN   3392
#define XCD_BAR_WORDS 3456
#define XB_SPIN_CAP (1u << 22)
__device__ __forceinline__ unsigned xb_ld(unsigned* p)              { return __hip_atomic_load(p, __ATOMIC_RELAXED, __HIP_MEMORY_SCOPE_AGENT); }
__device__ __forceinline__ unsigned xb_add(unsigned* p, unsigned v) { return __hip_atomic_fetch_add(p, v, __ATOMIC_RELAXED, __HIP_MEMORY_SCOPE_AGENT); }
__device__ __forceinline__ unsigned xb_xcc_id() { return (unsigned)__builtin_amdgcn_s_getreg((3 << 11) | 20) & 0xFu; }
#define XB_SPIN(cond, bar) do { unsigned _sp = 0; while (cond) { __builtin_amdgcn_s_sleep(1); \
    if ((++_sp & 255u) == 0u) { if (xb_ld(&(bar)[XB_TMO])) break; if (_sp > XB_SPIN_CAP) { atomicAdd(&(bar)[XB_TMO], 1u); break; } } } } while (0)
struct XcdBarrier { unsigned* bar; unsigned x; volatile LAS unsigned* st; };
__device__ __forceinline__ XcdBarrier xcd_barrier_post(unsigned* bar, volatile LAS unsigned* st) {
    XcdBarrier b; b.bar = bar; b.x = xb_xcc_id(); b.st = st;
    if (threadIdx.x == 0) (void)xb_add(&bar[XB_XCNT(b.x)], 1u);
    return b;
}
__device__ __forceinline__ void xcd_barrier_complete(unsigned* bar, unsigned x, unsigned& nloc, unsigned& nx) {
    const unsigned G = gridDim.x * gridDim.y * gridDim.z;
    unsigned sum, cnt, mine, sp = 0u;
    for (;;) {
        sum = 0u; cnt = 0u; mine = 0u;
#pragma unroll
        for (unsigned j = 0; j < 16; ++j) { const unsigned c = xb_ld(&bar[XB_XCNT(j)]); sum += c; cnt += (c > 0u) ? 1u : 0u; mine = (j == x) ? c : mine; }
        if (sum == G) break;
        __builtin_amdgcn_s_sleep(1);
        if ((++sp & 255u) == 0u) { if (xb_ld(&bar[XB_TMO])) break; if (sp > XB_SPIN_CAP) { atomicAdd(&bar[XB_TMO], 1u); break; } }
    }
    nloc = mine > 0u ? mine : 1u; nx = cnt > 0u ? cnt : 1u;
}
__device__ __forceinline__ void xcd_barrier(const XcdBarrier& b) {
    asm volatile("s_waitcnt vmcnt(0)" ::: "memory");
    __syncthreads();
    if (threadIdx.x == 0) {
        unsigned* bar = b.bar;
        __builtin_amdgcn_s_waitcnt(0);
        unsigned nloc = b.st[0], nx = b.st[1];
        if (nloc == 0u) { xcd_barrier_complete(bar, b.x, nloc, nx); b.st[0] = nloc; b.st[1] = nx; }
        const unsigned old = xb_add(&bar[XB_XSUB(b.x)], 1u);
        const unsigned gen = old / nloc;
        if (old + 1u == (gen + 1u) * nloc) {
            __builtin_amdgcn_fence(__ATOMIC_RELEASE, "agent");
            asm volatile("s_waitcnt vmcnt(0)" ::: "memory");
            const unsigned og = xb_add(&bar[XB_TOP], 1u);
            const unsigned tg = og / nx;
            if (og + 1u == (tg + 1u) * nx) xb_add(&bar[XB_TOPGEN], 1u);
            else XB_SPIN(xb_ld(&bar[XB_TOPGEN]) == tg, bar);
            __builtin_amdgcn_fence(__ATOMIC_ACQUIRE, "agent");
            xb_add(&bar[XB_XGEN(b.x)], 1u);
            asm volatile("s_waitcnt vmcnt(0)" ::: "memory");
        } else {
            XB_SPIN(xb_ld(&bar[XB_XGEN(b.x)]) == gen, bar);
            __builtin_amdgcn_fence(__ATOMIC_ACQUIRE, "agent");
            asm volatile("s_waitcnt vmcnt(0)" ::: "memory");
        }
    }
    __syncthreads();
}

constexpr int NG_LD = 132;
template <int NB>
__device__ __forceinline__ void ngemm_tile(float* lds, const bf16* A, int lda, long arow_src  , const float* B0, const float* B1, int ldb, int n0, int N, int K,
                                           float (&acc)[NB][8][4]) {
    const int tid = threadIdx.x;
    float* As = lds; float* Bs0 = lds + 16 * NG_LD; float* Bs1 = lds + 32 * NG_LD;
    const int ty = tid >> 5, tx = tid & 31;
    const int arow = tid >> 2, akq = (tid & 3) * 4;
    const int bk = tid >> 5, bn = (tid & 31) * 4;
    const bool bvalid = (n0 + bn) < N;
#pragma unroll
    for (int b = 0; b < NB; ++b)
#pragma unroll
        for (int i = 0; i < 8; ++i)
#pragma unroll
            for (int j = 0; j < 4; ++j) acc[b][i][j] = 0.f;
    for (int k0 = 0; k0 < K; k0 += 16) {
        u32x2 av = (u32x2){0u, 0u};
        if (arow_src >= 0) av = *(const u32x2*)(A + (size_t)arow_src * lda + k0 + akq);
        f32x4 bv0 = (f32x4){0.f, 0.f, 0.f, 0.f}, bv1 = (f32x4){0.f, 0.f, 0.f, 0.f};
        if (bvalid) { bv0 = *(const f32x4*)(B0 + (size_t)(k0 + bk) * ldb + n0 + bn); if (NB == 2) bv1 = *(const f32x4*)(B1 + (size_t)(k0 + bk) * ldb + n0 + bn); }
        __syncthreads();
        As[(akq + 0) * NG_LD + arow] = bf2f(av.x & 0xffffu); As[(akq + 1) * NG_LD + arow] = bf2f(av.x >> 16);
        As[(akq + 2) * NG_LD + arow] = bf2f(av.y & 0xffffu); As[(akq + 3) * NG_LD + arow] = bf2f(av.y >> 16);
        *(f32x4*)&Bs0[bk * NG_LD + bn] = bv0; if (NB == 2) *(f32x4*)&Bs1[bk * NG_LD + bn] = bv1;
        __syncthreads();
#pragma unroll 4
        for (int k = 0; k < 16; ++k) {
            const f32x4 a0 = *(const f32x4*)&As[k * NG_LD + ty * 8], a1 = *(const f32x4*)&As[k * NG_LD + ty * 8 + 4];
            const float a[8] = {a0.x, a0.y, a0.z, a0.w, a1.x, a1.y, a1.z, a1.w};
            const f32x4 b0 = *(const f32x4*)&Bs0[k * NG_LD + tx * 4];
#pragma unroll
            for (int i = 0; i < 8; ++i) { acc[0][i][0] += a[i] * b0.x; acc[0][i][1] += a[i] * b0.y; acc[0][i][2] += a[i] * b0.z; acc[0][i][3] += a[i] * b0.w; }
            if (NB == 2) { const f32x4 b1 = *(const f32x4*)&Bs1[k * NG_LD + tx * 4];
#pragma unroll
                for (int i = 0; i < 8; ++i) { acc[NB - 1][i][0] += a[i] * b1.x; acc[NB - 1][i][1] += a[i] * b1.y; acc[NB - 1][i][2] += a[i] * b1.z; acc[NB - 1][i][3] += a[i] * b1.w; } }
        }
    }
    __syncthreads();
}

__device__ __forceinline__ void ph0_prologue(const CParams& p) {
    const int lane = threadIdx.x & 63, wave = threadIdx.x >> 6;
    const float* x = p.in[0]; const float* nw = p.in[1]; bf16* XN = (bf16*)(p.ws + WS_XN);
    f32x4 w[4];
#pragma unroll
    for (int j = 0; j < 4; ++j) w[j] = ((const f32x4*)nw)[lane + 64 * j];
    for (int m = blockIdx.x * NWAVES + wave; m < M; m += gridDim.x * NWAVES) {
        const f32x4* xr = (const f32x4*)(x + (size_t)m * DM) + lane;
        f32x4 v[4]; float s = 0.f;
#pragma unroll
        for (int j = 0; j < 4; ++j) { v[j] = xr[64 * j]; s += (v[j].x * v[j].x + v[j].y * v[j].y) + (v[j].z * v[j].z + v[j].w * v[j].w); }
        const float rstd = rsqrtf(wave_sum(s) * (1.f / DM) + 1e-6f);
        u32x2* o = (u32x2*)(XN + (size_t)m * DM) + lane;
#pragma unroll
        for (int j = 0; j < 4; ++j) o[64 * j] = (u32x2){pk2(v[j].x * rstd * w[j].x, v[j].y * rstd * w[j].y), pk2(v[j].z * rstd * w[j].z, v[j].w * rstd * w[j].w)};
    }
}

__device__ __forceinline__ void ph1_win(const CParams& p, float* lds) {
    const int tid = threadIdx.x, ty = tid >> 5, tx = tid & 31;
    const bf16* XN = (const bf16*)(p.ws + WS_XN); const float* W = p.in[2];
    bf16* PRW = (bf16*)(p.ws + WS_PRW); bf16* PFOX = (bf16*)(p.ws + WS_PFOX);
    constexpr int NT_N = (IN_COLS + 127) / 128, NT_M = M / 128;
    for (int t = blockIdx.x; t < NT_M * NT_N; t += gridDim.x) {
        const int tm = t / NT_N, tn = t % NT_N, n0 = tn * 128;
        float acc[1][8][4];
        ngemm_tile<1>(lds, XN, DM, (long)tm * 128 + (tid >> 2), W, nullptr, IN_COLS, n0, IN_COLS, DM, acc);
        const int col = n0 + tx * 4;
        if (col < IN_COLS) {
#pragma unroll
            for (int i = 0; i < 8; ++i) {
                const size_t row = (size_t)tm * 128 + ty * 8 + i;
                const u32x2 o = (u32x2){pk2(acc[0][i][0], acc[0][i][1]), pk2(acc[0][i][2], acc[0][i][3])};
                if (col < RW_COLS) *(u32x2*)(PRW + row * RW_COLS + col) = o; else *(u32x2*)(PFOX + row * FOX_COLS + (col - RW_COLS)) = o;
            }
        }
    }
}

__device__ __forceinline__ void ph2_foxprep(const CParams& p) {
    const int lane = threadIdx.x & 63, wave = threadIdx.x >> 6;
    const bf16* PFOX = (const bf16*)(p.ws + WS_PFOX);
    bf16* QF = (bf16*)(p.ws + WS_QF); bf16* KF = (bf16*)(p.ws + WS_KF); bf16* VF = (bf16*)(p.ws + WS_VF); float* LOGF = (float*)(p.ws + WS_LOGF);
    const float qw = p.in[15][lane], kw = p.in[16][lane];
    for (int m = blockIdx.x * NWAVES + wave; m < M; m += gridDim.x * NWAVES) {
        const bf16* pr = PFOX + (size_t)m * FOX_COLS;
#pragma unroll
        for (int h = 0; h < 8; ++h) {
            const float q = bf2f(pr[h * 64 + lane]), k = bf2f(pr[512 + h * 64 + lane]);
            const float rq = rsqrtf(wave_sum(q * q) * (1.f / 64.f) + 1e-6f), rk = rsqrtf(wave_sum(k * k) * (1.f / 64.f) + 1e-6f);
            QF[(size_t)m * 512 + h * 64 + lane] = (bf16)f2bf(q * rq * qw * QSCALE);
            KF[(size_t)m * 512 + h * 64 + lane] = (bf16)f2bf(k * rk * kw);
            VF[(size_t)m * 512 + h * 64 + lane] = pr[1024 + h * 64 + lane];
        }
        if (lane < 8) { const float z = bf2f(pr[1536 + lane]) + p.in[14][lane]; LOGF[(size_t)m * 8 + lane] = -softplusf_(-z); }
    }
}

__device__ __forceinline__ void ph3_cumsum(const CParams& p, float* lds) {
    if (blockIdx.x >= 32) return;
    const int tid = threadIdx.x, b = blockIdx.x >> 3, h = blockIdx.x & 7;
    const float* LOGF = (const float*)(p.ws + WS_LOGF); float* CUMF = (float*)(p.ws + WS_CUMF);
    float v[16]; float run = 0.f;
#pragma unroll
    for (int i = 0; i < 16; ++i) { run += LOGF[((size_t)b * SEQ + tid * 16 + i) * 8 + h]; v[i] = run; }
    lds[tid] = run; __syncthreads();
    for (int off = 1; off < 512; off <<= 1) { float a = (tid >= off) ? lds[tid - off] : 0.f; __syncthreads(); lds[tid] += a; __syncthreads(); }
    const float base = lds[tid] - run;
#pragma unroll
    for (int i = 0; i < 16; ++i) CUMF[((size_t)b * SEQ + tid * 16 + i) * 8 + h] = base + v[i];
}

__device__ __forceinline__ void ph4_attn(const CParams& p, float* lds) {
    const int tid = threadIdx.x, qi = tid >> 3, sub = tid & 7;
    const bf16* QF = (const bf16*)(p.ws + WS_QF); const bf16* KF = (const bf16*)(p.ws + WS_KF); const bf16* VF = (const bf16*)(p.ws + WS_VF);
    const float* CUMF = (const float*)(p.ws + WS_CUMF); bf16* YMIX = (bf16*)(p.ws + WS_YMIX);
    float* Qs = lds; float* Ks = Qs + 64 * 68; float* Vs = Ks + 64 * 68; float* Ps = Vs + 64 * 68; float* Cs = Ps + 64 * 65;
    for (int u = blockIdx.x; u < 32 * 128; u += gridDim.x) {
        const int qblk = 127 - (u >> 5), bh = u & 31, b = bh >> 3, h = bh & 7, q0 = qblk * 64;
        const size_t rowbase = (size_t)b * SEQ;
        { const u32x4 v = *(const u32x4*)(QF + (rowbase + q0 + qi) * 512 + h * 64 + sub * 8); float* d = Qs + qi * 68 + sub * 8;
          d[0] = bf2f(v.x & 0xffffu); d[1] = bf2f(v.x >> 16); d[2] = bf2f(v.y & 0xffffu); d[3] = bf2f(v.y >> 16); d[4] = bf2f(v.z & 0xffffu); d[5] = bf2f(v.z >> 16); d[6] = bf2f(v.w & 0xffffu); d[7] = bf2f(v.w >> 16); }
        const float cq = CUMF[(rowbase + q0 + qi) * 8 + h] * LOG2E;
        float m_run = -1e30f, l_run = 0.f, o[8];
#pragma unroll
        for (int i = 0; i < 8; ++i) o[i] = 0.f;
        for (int kt = 0; kt <= qblk; ++kt) {
            __syncthreads();
            { const u32x4 kv = *(const u32x4*)(KF + (rowbase + kt * 64 + qi) * 512 + h * 64 + sub * 8); float* d = Ks + qi * 68 + sub * 8;
              d[0] = bf2f(kv.x & 0xffffu); d[1] = bf2f(kv.x >> 16); d[2] = bf2f(kv.y & 0xffffu); d[3] = bf2f(kv.y >> 16); d[4] = bf2f(kv.z & 0xffffu); d[5] = bf2f(kv.z >> 16); d[6] = bf2f(kv.w & 0xffffu); d[7] = bf2f(kv.w >> 16);
              const u32x4 vv = *(const u32x4*)(VF + (rowbase + kt * 64 + qi) * 512 + h * 64 + sub * 8); float* e = Vs + qi * 68 + sub * 8;
              e[0] = bf2f(vv.x & 0xffffu); e[1] = bf2f(vv.x >> 16); e[2] = bf2f(vv.y & 0xffffu); e[3] = bf2f(vv.y >> 16); e[4] = bf2f(vv.z & 0xffffu); e[5] = bf2f(vv.z >> 16); e[6] = bf2f(vv.w & 0xffffu); e[7] = bf2f(vv.w >> 16); }
            if (tid < 64) Cs[tid] = CUMF[(rowbase + kt * 64 + tid) * 8 + h] * LOG2E;
            __syncthreads();
            float s[8];
#pragma unroll
            for (int j = 0; j < 8; ++j) s[j] = 0.f;
#pragma unroll
            for (int d4 = 0; d4 < 16; ++d4) {
                const f32x4 q4 = *(const f32x4*)&Qs[qi * 68 + d4 * 4];
#pragma unroll
                for (int j = 0; j < 8; ++j) { const f32x4 k4 = *(const f32x4*)&Ks[(sub + 8 * j) * 68 + d4 * 4]; s[j] += (q4.x * k4.x + q4.y * k4.y) + (q4.z * k4.z + q4.w * k4.w); }
            }
            float mx = -1e30f;
#pragma unroll
            for (int j = 0; j < 8; ++j) { const int kv = kt * 64 + sub + 8 * j; s[j] += cq - Cs[sub + 8 * j]; if (kv > q0 + qi) s[j] = -INFINITY; mx = fmaxf(mx, s[j]); }
            mx = fmaxf(mx, __shfl_xor(mx, 1)); mx = fmaxf(mx, __shfl_xor(mx, 2)); mx = fmaxf(mx, __shfl_xor(mx, 4));
            const float m_new = fmaxf(m_run, mx), alpha = __builtin_amdgcn_exp2f(m_run - m_new);
            float ps = 0.f;
#pragma unroll
            for (int j = 0; j < 8; ++j) { const float pj = __builtin_amdgcn_exp2f(s[j] - m_new); ps += pj; Ps[qi * 65 + sub + 8 * j] = pj; }
            ps += __shfl_xor(ps, 1); ps += __shfl_xor(ps, 2); ps += __shfl_xor(ps, 4);
            l_run = l_run * alpha + ps; m_run = m_new;
#pragma unroll
            for (int i = 0; i < 8; ++i) o[i] *= alpha;
            __syncthreads();
#pragma unroll 8
            for (int kv = 0; kv < 64; ++kv) {
                const float pv = Ps[qi * 65 + kv]; const f32x4 v0 = *(const f32x4*)&Vs[kv * 68 + sub * 8], v1 = *(const f32x4*)&Vs[kv * 68 + sub * 8 + 4];
                o[0] += pv * v0.x; o[1] += pv * v0.y; o[2] += pv * v0.z; o[3] += pv * v0.w; o[4] += pv * v1.x; o[5] += pv * v1.y; o[6] += pv * v1.z; o[7] += pv * v1.w;
            }
        }
        const float inv = 1.f / l_run;
        *(u32x4*)(YMIX + (rowbase + q0 + qi) * DM + 512 + h * 64 + sub * 8) = (u32x4){pk2(o[0] * inv, o[1] * inv), pk2(o[2] * inv, o[3] * inv), pk2(o[4] * inv, o[5] * inv), pk2(o[6] * inv, o[7] * inv)};
    }
}

__device__ __forceinline__ float shifted(const bf16* PRW, const float* mu, size_t m, int c) {
    const float cur = bf2f(PRW[m * RW_COLS + c]);
    const float prev = ((m % SEQ) == 0) ? 0.f : bf2f(PRW[(m - 1) * RW_COLS + c]);
    return cur + (prev - cur) * mu[c];
}

__device__ __forceinline__ void ph5_rwprep(const CParams& p, float* lds) {
    const int tid = threadIdx.x, ch = tid;
    const bf16* PRW = (const bf16*)(p.ws + WS_PRW); const float* mu = p.in[3];
    float* LD = (float*)(p.ws + WS_LD); bf16* K2 = (bf16*)(p.ws + WS_K2); bf16* KK = (bf16*)(p.ws + WS_KK); bf16* BB = (bf16*)(p.ws + WS_BB); bf16* Gb = (bf16*)(p.ws + WS_G);
    const float* w0 = p.in[4]; const float* w2 = p.in[5]; const float* a0 = p.in[6]; const float* a2 = p.in[7]; const float* g2 = p.in[8];
    const float kkw = p.in[9][ch], kaw = p.in[10][ch], w0c = w0[ch], a0c = a0[ch];
    float* Xs = lds;
    for (int grp = blockIdx.x; grp < M / 8; grp += gridDim.x) {
        const size_t m0 = (size_t)grp * 8;
        __syncthreads();
#pragma unroll
        for (int i = 0; i < 4; ++i) {
            const int idx = tid * 4 + i, tk = idx >> 8, c = idx & 255;
            const int col = c < 64 ? C_PW + c : (c < 128 ? C_PA + (c - 64) : C_PG + (c - 128));
            float v = shifted(PRW, mu, m0 + tk, col);
            v = c < 64 ? tanhf(v) : (c < 128 ? v : sigmoidf_(v));
            Xs[idx] = v;
        }
        __syncthreads();
        float accw[8], acca[8], accg[8];
#pragma unroll
        for (int t = 0; t < 8; ++t) { accw[t] = 0.f; acca[t] = 0.f; accg[t] = 0.f; }
        for (int j = 0; j < 64; ++j) { const float wv = w2[j * 512 + ch], av = a2[j * 512 + ch];
#pragma unroll
            for (int t = 0; t < 8; ++t) { accw[t] += Xs[t * 256 + j] * wv; acca[t] += Xs[t * 256 + 64 + j] * av; } }
        for (int j = 0; j < 128; ++j) { const float gv = g2[j * 512 + ch];
#pragma unroll
            for (int t = 0; t < 8; ++t) accg[t] += Xs[t * 256 + 128 + j] * gv; }
#pragma unroll
        for (int t = 0; t < 8; ++t) {
            const size_t m = m0 + t;
            const float kraw = shifted(PRW, mu, m, C_K + ch);
            const float wlog = -softplusf_(-(w0c + accw[t])) - 0.5f;
            LD[m * 512 + ch] = -__expf(wlog);
            const float al = sigmoidf_(a0c + acca[t]);
            const float kkv = kraw * kkw;
            const float nrm = fmaxf(sqrtf(wave_sum(kkv * kkv)), 1e-12f);
            const float kk = kkv / nrm;
            K2[m * 512 + ch] = (bf16)f2bf(kraw * (1.f + (al - 1.f) * kaw));
            KK[m * 512 + ch] = (bf16)f2bf(kk);
            BB[m * 512 + ch] = (bf16)f2bf(kk * al);
            Gb[m * 512 + ch] = (bf16)f2bf(accg[t]);
        }
    }
}

__device__ __forceinline__ void ph6_scan(const CParams& p, float* lds) {
    if (blockIdx.x >= 32) return;
    const int tid = threadIdx.x, b = blockIdx.x >> 3, h = blockIdx.x & 7, vi = tid >> 3, q = tid & 7;
    const bf16* PRW = (const bf16*)(p.ws + WS_PRW); const float* mu = p.in[3];
    const float* LD = (const float*)(p.ws + WS_LD); const bf16* K2 = (const bf16*)(p.ws + WS_K2); const bf16* KK = (const bf16*)(p.ws + WS_KK); const bf16* BB = (const bf16*)(p.ws + WS_BB);
    float* Y = (float*)(p.ws + WS_Y);
    float* Rs = lds; float* Ws = Rs + 2048; float* Ks = Ws + 2048; float* As = Ks + 2048; float* Bs = As + 2048; float* Vs = Bs + 2048; float* Ys = Vs + 2048;
    float S[8];
#pragma unroll
    for (int j = 0; j < 8; ++j) S[j] = 0.f;
    for (int c0 = 0; c0 < SEQ; c0 += 32) {
        __syncthreads();
#pragma unroll
        for (int i = 0; i < 4; ++i) {
            const int idx = tid * 4 + i, t = idx >> 6, c = idx & 63; const size_t m = (size_t)b * SEQ + c0 + t; const int col = h * 64 + c;
            Rs[idx] = shifted(PRW, mu, m, C_R + col); Vs[idx] = shifted(PRW, mu, m, C_V + col);
            Ws[idx] = __expf(LD[m * 512 + col]); Ks[idx] = bf2f(K2[m * 512 + col]); As[idx] = -bf2f(KK[m * 512 + col]); Bs[idx] = bf2f(BB[m * 512 + col]);
        }
        __syncthreads();
        for (int t = 0; t < 32; ++t) {
            const f32x4 a0 = *(const f32x4*)&As[t * 64 + q * 8], a1 = *(const f32x4*)&As[t * 64 + q * 8 + 4];
            float sa = (S[0] * a0.x + S[1] * a0.y) + (S[2] * a0.z + S[3] * a0.w) + (S[4] * a1.x + S[5] * a1.y) + (S[6] * a1.z + S[7] * a1.w);
            sa += __shfl_xor(sa, 1); sa += __shfl_xor(sa, 2); sa += __shfl_xor(sa, 4);
            const float vv = Vs[t * 64 + vi];
            const f32x4 w0 = *(const f32x4*)&Ws[t * 64 + q * 8], w1 = *(const f32x4*)&Ws[t * 64 + q * 8 + 4];
            const f32x4 b0 = *(const f32x4*)&Bs[t * 64 + q * 8], b1 = *(const f32x4*)&Bs[t * 64 + q * 8 + 4];
            const f32x4 k0 = *(const f32x4*)&Ks[t * 64 + q * 8], k1 = *(const f32x4*)&Ks[t * 64 + q * 8 + 4];
            const f32x4 r0 = *(const f32x4*)&Rs[t * 64 + q * 8], r1 = *(const f32x4*)&Rs[t * 64 + q * 8 + 4];
            S[0] = S[0] * w0.x + sa * b0.x + vv * k0.x; S[1] = S[1] * w0.y + sa * b0.y + vv * k0.y; S[2] = S[2] * w0.z + sa * b0.z + vv * k0.z; S[3] = S[3] * w0.w + sa * b0.w + vv * k0.w;
            S[4] = S[4] * w1.x + sa * b1.x + vv * k1.x; S[5] = S[5] * w1.y + sa * b1.y + vv * k1.y; S[6] = S[6] * w1.z + sa * b1.z + vv * k1.z; S[7] = S[7] * w1.w + sa * b1.w + vv * k1.w;
            float y = (S[0] * r0.x + S[1] * r0.y) + (S[2] * r0.z + S[3] * r0.w) + (S[4] * r1.x + S[5] * r1.y) + (S[6] * r1.z + S[7] * r1.w);
            y += __shfl_xor(y, 1); y += __shfl_xor(y, 2); y += __shfl_xor(y, 4);
            if (q == 0) Ys[t * 64 + vi] = y;
        }
        __syncthreads();
#pragma unroll
        for (int i = 0; i < 4; ++i) { const int idx = tid * 4 + i, t = idx >> 6, c = idx & 63; Y[((size_t)b * SEQ + c0 + t) * 512 + h * 64 + c] = Ys[idx]; }
    }
}

__device__ __forceinline__ void ph7_rwpost(const CParams& p) {
    const int lane = threadIdx.x & 63, wave = threadIdx.x >> 6;
    const bf16* PRW = (const bf16*)(p.ws + WS_PRW); const float* mu = p.in[3];
    const float* Y = (const float*)(p.ws + WS_Y); const bf16* K2 = (const bf16*)(p.ws + WS_K2); const bf16* Gb = (const bf16*)(p.ws + WS_G); bf16* YMIX = (bf16*)(p.ws + WS_YMIX);
    for (int m = blockIdx.x * NWAVES + wave; m < M; m += gridDim.x * NWAVES) {
#pragma unroll
        for (int h = 0; h < 8; ++h) {
            const int c = h * 64 + lane;
            const float y = Y[(size_t)m * 512 + c];
            const float mean = wave_sum(y) * (1.f / 64.f), d = y - mean, var = wave_sum(d * d) * (1.f / 64.f);
            const float yn = d * rsqrtf(var + 64e-5f) * p.in[12][c] + p.in[13][c];
            const float r = shifted(PRW, mu, m, C_R + c), v = shifted(PRW, mu, m, C_V + c), k2 = bf2f(K2[(size_t)m * 512 + c]);
            const float bonus = wave_sum(r * k2 * p.in[11][c]) * v;
            YMIX[(size_t)m * DM + c] = (bf16)f2bf((yn + bonus) * bf2f(Gb[(size_t)m * 512 + c]));
        }
    }
}

__device__ __forceinline__ void ph8_wout(const CParams& p, float* lds) {
    const int tid = threadIdx.x, ty = tid >> 5, tx = tid & 31;
    const bf16* YMIX = (const bf16*)(p.ws + WS_YMIX); const float* W = p.in[17]; const float* x = p.in[0];
    for (int t = blockIdx.x; t < (M / 128) * 8; t += gridDim.x) {
        const int tm = t >> 3, tn = t & 7, n0 = tn * 128;
        float acc[1][8][4];
        ngemm_tile<1>(lds, YMIX, DM, (long)tm * 128 + (tid >> 2), W, nullptr, DM, n0, DM, DM, acc);
#pragma unroll
        for (int i = 0; i < 8; ++i) { const size_t off = ((size_t)tm * 128 + ty * 8 + i) * DM + n0 + tx * 4; const f32x4 xv = *(const f32x4*)(x + off);
            *(f32x4*)(p.out + off) = (f32x4){xv.x + acc[0][i][0], xv.y + acc[0][i][1], xv.z + acc[0][i][2], xv.w + acc[0][i][3]}; }
    }
}

__device__ __forceinline__ void ph9_route(const CParams& p, float* lds) {
    const int lane = threadIdx.x & 63, wave = threadIdx.x >> 6;
    bf16* H2 = (bf16*)(p.ws + WS_H2); int* EID = (int*)(p.ws + WS_EID); float* GATE = (float*)(p.ws + WS_GATE); int* RANK = (int*)(p.ws + WS_RANK);
    int* CNT = (int*)(p.ws + WS_CTL) + CW_CNT;
    const float* nw = p.in[18]; const float* rgw = p.in[19]; const float* rgb = p.in[20]; const float* rew = p.in[21]; const float* reb = p.in[22];
    float* Hs = lds + wave * 1024;
    f32x4 w[4];
#pragma unroll
    for (int j = 0; j < 4; ++j) w[j] = ((const f32x4*)nw)[lane + 64 * j];
    for (int grp = blockIdx.x; grp < M / 8; grp += gridDim.x) {
        const size_t m = (size_t)grp * 8 + wave;
        const f32x4* xr = (const f32x4*)(p.out + m * DM) + lane;
        f32x4 v[4]; float s = 0.f;
#pragma unroll
        for (int j = 0; j < 4; ++j) { v[j] = xr[64 * j]; s += (v[j].x * v[j].x + v[j].y * v[j].y) + (v[j].z * v[j].z + v[j].w * v[j].w); }
        const float rstd = rsqrtf(wave_sum(s) * (1.f / DM) + 1e-6f);
        __syncthreads();
#pragma unroll
        for (int j = 0; j < 4; ++j) { const f32x4 hv = (f32x4){v[j].x * rstd * w[j].x, v[j].y * rstd * w[j].y, v[j].z * rstd * w[j].z, v[j].w * rstd * w[j].w};
            *(f32x4*)&Hs[(lane + 64 * j) * 4] = hv; ((u32x2*)(H2 + m * DM))[lane + 64 * j] = (u32x2){pk2(hv.x, hv.y), pk2(hv.z, hv.w)}; }
        __syncthreads();
        float el = 0.f, gl = 0.f;
#pragma unroll 8
        for (int k = 0; k < DM; ++k) { const float hk = Hs[k]; el += hk * rew[k * 64 + lane]; gl += hk * rgw[k * 8 + (lane & 7)]; }
        el += reb[lane]; gl += rgb[lane & 7];
        float best = -INFINITY; int bi = 0;
#pragma unroll
        for (int j = 0; j < 8; ++j) { const float vj = __shfl(gl, j); if (vj > best) { best = vj; bi = j; } }
        float gs = 0.f;
#pragma unroll
        for (int j = 0; j < 8; ++j) gs += __expf(__shfl(gl, j) - best);
        const float ggate = 1.f / gs;
        float t1 = -INFINITY, t2 = -INFINITY; int i1 = 0, i2 = 0;
#pragma unroll
        for (int j = 0; j < 8; ++j) { const float vj = __shfl(el, bi * 8 + j); if (vj > t1) { t2 = t1; i2 = i1; t1 = vj; i1 = j; } else if (vj > t2) { t2 = vj; i2 = j; } }
        const float p1 = 1.f / (1.f + __expf(t2 - t1)), p2 = 1.f - p1;
        if (lane == 0) {
            const int s0 = bi * 8 + i1, s1 = 64 + bi * 8 + i2;
            EID[m * 2] = s0; EID[m * 2 + 1] = s1; GATE[m * 2] = ggate * p1; GATE[m * 2 + 1] = ggate * p2;
            RANK[m * 2] = atomicAdd(&CNT[s0], 1); RANK[m * 2 + 1] = atomicAdd(&CNT[s1], 1);
        }
    }
}

constexpr int RT = 128;
__device__ __forceinline__ int seg_table(const CParams& p, int* offs, int* cnts) {
    const int* CNT = (const int*)(p.ws + WS_CTL) + CW_CNT;
    __syncthreads();
    if (threadIdx.x < NSEG) cnts[threadIdx.x] = __hip_atomic_load(CNT + threadIdx.x, __ATOMIC_RELAXED, __HIP_MEMORY_SCOPE_AGENT);
    __syncthreads();
    if (threadIdx.x == 0) { int run = 0; for (int s = 0; s < NSEG; ++s) { offs[s] = run; run += (cnts[s] + RT - 1) / RT; } offs[NSEG] = run; }
    __syncthreads();
    return offs[NSEG];
}
__device__ __forceinline__ int seg_of_tile(const int* offs, int rt) { int s = 0; for (int k = 64; k > 0; k >>= 1) if (offs[s + k] <= rt) s += k; return s; }

__device__ __forceinline__ void ph10_lists(const CParams& p, float* lds) {
    int* offs = (int*)lds; int* cnts = offs + 160;
    seg_table(p, offs, cnts);
    const int* EID = (const int*)(p.ws + WS_EID); const float* GATE = (const float*)(p.ws + WS_GATE); const int* RANK = (const int*)(p.ws + WS_RANK);
    int* LIST = (int*)(p.ws + WS_LIST); float* LG = (float*)(p.ws + WS_LG);
    for (int a = blockIdx.x * NTHREADS + threadIdx.x; a < M * 2; a += gridDim.x * NTHREADS) {
        const int s = EID[a], pos = offs[s] * RT + RANK[a];
        LIST[pos] = a >> 1; LG[pos] = GATE[a];
    }
}

__device__ __forceinline__ void ph11_gateup(const CParams& p, float* lds) {
    const int tid = threadIdx.x, ty = tid >> 5, tx = tid & 31;
    int* offs = (int*)(lds + 48 * NG_LD); int* cnts = offs + 160;
    const int ntile = seg_table(p, offs, cnts);
    const bf16* H2 = (const bf16*)(p.ws + WS_H2); const int* LIST = (const int*)(p.ws + WS_LIST); bf16* HID = (bf16*)(p.ws + WS_HID);
    for (int t = blockIdx.x; t < ntile * 4; t += gridDim.x) {
        const int rt = t >> 2, ct = t & 3, s = seg_of_tile(offs, rt), e = s & 63, r0 = (rt - offs[s]) * RT, nvalid = cnts[s] - r0;
        const int arow = tid >> 2;
        const long src = (arow < nvalid) ? (long)LIST[rt * RT + arow] : -1;
        float acc[2][8][4];
        ngemm_tile<2>(lds, H2, DM, src, p.in[23] + (size_t)e * DM * DEXP, p.in[24] + (size_t)e * DM * DEXP, DEXP, ct * 128, DEXP, DM, acc);
#pragma unroll
        for (int i = 0; i < 8; ++i) { const int row = ty * 8 + i;
            if (row < nvalid) { float hv[4];
#pragma unroll
                for (int j = 0; j < 4; ++j) { const float g = acc[0][i][j]; hv[j] = g * sigmoidf_(g) * acc[1][i][j]; }
                *(u32x2*)(HID + ((size_t)rt * RT + row) * DEXP + ct * 128 + tx * 4) = (u32x2){pk2(hv[0], hv[1]), pk2(hv[2], hv[3])}; } }
    }
}

__device__ __forceinline__ void ph12_down(const CParams& p, float* lds) {
    const int tid = threadIdx.x, ty = tid >> 5, tx = tid & 31;
    int* offs = (int*)(lds + 48 * NG_LD); int* cnts = offs + 160;
    const int ntile = seg_table(p, offs, cnts);
    const bf16* HID = (const bf16*)(p.ws + WS_HID); const int* LIST = (const int*)(p.ws + WS_LIST); const float* LG = (const float*)(p.ws + WS_LG);
    for (int t = blockIdx.x; t < ntile * 8; t += gridDim.x) {
        const int rt = t >> 3, ct = t & 7, s = seg_of_tile(offs, rt), e = s & 63, r0 = (rt - offs[s]) * RT, nvalid = cnts[s] - r0;
        const int arow = tid >> 2;
        const long src = (arow < nvalid) ? (long)rt * RT + arow : -1;
        float acc[1][8][4];
        ngemm_tile<1>(lds, HID, DEXP, src, p.in[25] + (size_t)e * DEXP * DM, nullptr, DM, ct * 128, DM, DEXP, acc);
#pragma unroll
        for (int i = 0; i < 8; ++i) { const int row = ty * 8 + i;
            if (row < nvalid) { const int tok = LIST[rt * RT + row]; const float g = LG[rt * RT + row]; float* o = p.out + (size_t)tok * DM + ct * 128 + tx * 4;
#pragma unroll
                for (int j = 0; j < 4; ++j) atomicAdd(o + j, g * acc[0][i][j]); } }
    }
}

__global__ void __launch_bounds__(NTHREADS, 2) fwd_kernel(Params p_unused) {
    extern __shared__ __attribute__((aligned(16))) unsigned char lds_raw[];
    float* lds = (float*)lds_raw;
    const CParams* kp = (const CParams*)__builtin_amdgcn_kernarg_segment_ptr();
#define P (*kp_launder(kp))
    volatile LAS unsigned* MISC = (volatile LAS unsigned*)((LAS unsigned char*)lds_raw + LDS_BYTES - 256);
    if (threadIdx.x < 64) MISC[threadIdx.x] = 0u;
    __syncthreads();
    XcdBarrier bar; bar.bar = (unsigned*)(kp->ws + WS_CTL) + CW_BAR; bar.x = 0; bar.st = nullptr;
    if (N_LAUNCHES == 1) bar = xcd_barrier_post((unsigned*)(kp->ws + WS_CTL) + CW_BAR, MISC + 8);
    const int lo = kp->ph_lo, hi = kp->ph_hi;
#ifdef ONLY_PHASE
#define IN(k) ((k) == ONLY_PHASE && lo <= (k) && (k) < hi)
#elif defined(PHASE_MASK)
#define IN(k) (((PHASE_MASK >> (k)) & 1) && lo <= (k) && (k) < hi)
#else
#define IN(k) (lo <= (k) && (k) < hi)
#endif
#define SEAM(k) do { if (IN(k) && IN((k) + 1)) xcd_barrier(bar); } while (0)
    if (IN(0)) ph0_prologue(P);
    SEAM(0);
    if (IN(1)) ph1_win(P, lds);
    SEAM(1);
    if (IN(2)) ph2_foxprep(P);
    SEAM(2);
    if (IN(3)) ph3_cumsum(P, lds);
    SEAM(3);
    if (IN(4)) ph4_attn(P, lds);
    SEAM(4);
    if (IN(5)) ph5_rwprep(P, lds);
    SEAM(5);
    if (IN(6)) ph6_scan(P, lds);
    SEAM(6);
    if (IN(7)) ph7_rwpost(P);
    SEAM(7);
    if (IN(8)) ph8_wout(P, lds);
    SEAM(8);
    if (IN(9)) ph9_route(P, lds);
    SEAM(9);
    if (IN(10)) ph10_lists(P, lds);
    SEAM(10);
    if (IN(11)) ph11_gateup(P, lds);
    SEAM(11);
    if (IN(12)) ph12_down(P, lds);
#undef IN
#undef SEAM
#undef P
}

extern "C" void kernel_launch(void* const* d_in, const int* in_sizes, int n_in, void* d_out, int out_size, void* d_ws, size_t ws_size, hipStream_t stream) {
    static int grid = 0;
    if (grid == 0) {
        if (n_in != 26 || in_sizes[0] != M * DM || out_size != M * DM || ws_size < WS_END) { fprintf(stderr, "kernel_launch: unexpected shapes / workspace (n_in %d, ws %zu)\n", n_in, ws_size); grid = -1; return; }
        int dev = 0, cus = 0, per_cu = 0;
        if (hipGetDevice(&dev) != hipSuccess || hipDeviceGetAttribute(&cus, hipDeviceAttributeMultiprocessorCount, dev) != hipSuccess) { grid = -1; return; }
        if (hipFuncSetAttribute((const void*)fwd_kernel, hipFuncAttributeMaxDynamicSharedMemorySize, LDS_BYTES) != hipSuccess) { fprintf(stderr, "kernel_launch: hipFuncSetAttribute failed\n"); grid = -1; return; }
        if (hipOccupancyMaxActiveBlocksPerMultiprocessor(&per_cu, (const void*)fwd_kernel, NTHREADS, LDS_BYTES) != hipSuccess || per_cu < 1) { fprintf(stderr, "kernel_launch: occupancy query failed (%d)\n", per_cu); (void)hipGetLastError(); per_cu = 1; }
        grid = cus * per_cu;
    }
    if (grid < 0) return;
    (void)hipMemsetAsync((char*)d_ws + WS_CTL, 0, CTL_ZERO_BYTES, stream);
    Params a{};
    for (int i = 0; i < 26; ++i) a.in[i] = (const float*)d_in[i];
    a.out = (float*)d_out; a.ws = (unsigned char*)d_ws;
    if (N_LAUNCHES == 1) {
        a.ph_lo = 0; a.ph_hi = NPHASE; a.li = 0;
        void* args[] = {&a};
        hipError_t e = hipLaunchCooperativeKernel((const void*)fwd_kernel, dim3(grid), dim3(NTHREADS), args, LDS_BYTES, stream);
        if (e != hipSuccess) fprintf(stderr, "kernel_launch: cooperative launch failed: %s (grid %d)\n", hipGetErrorString(e), grid);
    } else {
        for (int li = 0; li < NPHASE; ++li) {
            a.ph_lo = li; a.ph_hi = li + 1; a.li = li;
            hipLaunchKernelGGL(fwd_kernel, dim3(grid), dim3(NTHREADS), LDS_BYTES, stream, a);
        }
    }
}
```

```cpp
#include <hip/hip_runtime.h>
#include <cstdio>
#include <cstdint>

#ifndef MK_N_LAUNCHES
#define MK_N_LAUNCHES 1
#endif

#define GAS __attribute__((address_space(1)))
#define LAS __attribute__((address_space(3)))
typedef unsigned short bf16;
typedef float f32x4 __attribute__((ext_vector_type(4)));
typedef unsigned u32x4 __attribute__((ext_vector_type(4)));
typedef unsigned u32x2 __attribute__((ext_vector_type(2)));

constexpr int BATCH = 4, SEQ = 8192, DM = 1024, M = BATCH * SEQ;
constexpr int RW_COLS = 1792, FOX_COLS = 1544, IN_COLS = 3336;
constexpr int C_R = 0, C_PW = 512, C_K = 576, C_V = 1088, C_PA = 1600, C_PG = 1664;
constexpr int NEXP = 64, DEXP = 512, NSEG = 128;
constexpr float LOG2E = 1.4426950408889634f;
constexpr float QSCALE = 0.125f * LOG2E;
constexpr int NWAVES = 8, NTHREADS = 512;
constexpr int NPHASE = 13;
constexpr int N_LAUNCHES = MK_N_LAUNCHES;
constexpr int LDS_BYTES = 147456;

constexpr size_t MiB = 1u << 20;
constexpr size_t WS_CTL = 0, CTL_ZERO_BYTES = 1 * MiB;
constexpr size_t WS_XN = 16 * MiB;
constexpr size_t WS_QF = 16 * MiB, WS_KF = 48 * MiB;
constexpr size_t WS_LD = 16 * MiB;
constexpr size_t WS_H2 = 16 * MiB;
constexpr size_t WS_YMIX = 80 * MiB;
constexpr size_t WS_LIST = 80 * MiB, WS_LG = 82 * MiB;
constexpr size_t WS_PRW = 144 * MiB;
constexpr size_t WS_HID = 144 * MiB;
constexpr size_t WS_PFOX = 256 * MiB;
constexpr size_t WS_K2 = 256 * MiB, WS_KK = 288 * MiB, WS_BB = 320 * MiB;
constexpr size_t WS_VF = 353 * MiB;
constexpr size_t WS_G = 353 * MiB;
constexpr size_t WS_LOGF = 385 * MiB, WS_CUMF = 386 * MiB;
constexpr size_t WS_EID = 387 * MiB;
constexpr size_t WS_GATE = WS_EID + 256 * 1024, WS_RANK = WS_GATE + 256 * 1024;
constexpr size_t WS_Y = 388 * MiB;
constexpr size_t WS_END = 452 * MiB;
constexpr int CW_CNT = 64;
constexpr int CW_BAR = 4096;

struct Params {
    const float* in[26];
    float* out;
    unsigned char* ws;
    int ph_lo, ph_hi, li, pad;
};
#define CAS __attribute__((address_space(4)))
typedef CAS Params CParams;
__device__ __forceinline__ const CParams* kp_launder(const CParams* q) { asm volatile("" : "+s"(q)); return q; }

__device__ __forceinline__ float bf2f(unsigned u) { return __uint_as_float(u << 16); }
__device__ __forceinline__ unsigned f2bf(float f) { unsigned u = __float_as_uint(f); return (u + 0x7fffu + ((u >> 16) & 1u)) >> 16; }
__device__ __forceinline__ unsigned pk2(float lo, float hi) { return f2bf(lo) | (f2bf(hi) << 16); }
__device__ __forceinline__ float wave_sum(float v) {
#pragma unroll
    for (int o = 1; o < 64; o <<= 1) v += __shfl_xor(v, o);
    return v;
}
__device__ __forceinline__ float sigmoidf_(float x) { return 1.0f / (1.0f + __expf(-x)); }
__device__ __forceinline__ float softplusf_(float z) { return fmaxf(z, 0.f) + log1pf(__expf(-fabsf(z))); }

#define XB_TMO      128
#define XB_XCNT(j)  (256  + 64 * (j))
#define XB_XSUB(j)  (1280 + 64 * (j))
#define XB_XGEN(j)  (2304 + 64 * (j))
#define XB_TOP      3328
#define XB_TOPGEN   3392
#define XCD_BAR_WORDS 3456
#define XB_SPIN_CAP (1u << 22)
__device__ __forceinline__ unsigned xb_ld(unsigned* p)              { return __hip_atomic_load(p, __ATOMIC_RELAXED, __HIP_MEMORY_SCOPE_AGENT); }
__device__ __forceinline__ unsigned xb_add(unsigned* p, unsigned v) { return __hip_atomic_fetch_add(p, v, __ATOMIC_RELAXED, __HIP_MEMORY_SCOPE_AGENT); }
__device__ __forceinline__ unsigned xb_xcc_id() { return (unsigned)__builtin_amdgcn_s_getreg((3 << 11) | 20) & 0xFu; }
#define XB_SPIN(cond, bar) do { unsigned _sp = 0; while (cond) { __builtin_amdgcn_s_sleep(1); \
    if ((++_sp & 255u) == 0u) { if (xb_ld(&(bar)[XB_TMO])) break; if (_sp > XB_SPIN_CAP) { atomicAdd(&(bar)[XB_TMO], 1u); break; } } } } while (0)
struct XcdBarrier { unsigned* bar; unsigned x; volatile LAS unsigned* st; };
__device__ __forceinline__ XcdBarrier xcd_barrier_post(unsigned* bar, volatile LAS unsigned* st) {
    XcdBarrier b; b.bar = bar; b.x = xb_xcc_id(); b.st = st;
    if (threadIdx.x == 0) (void)xb_add(&bar[XB_XCNT(b.x)], 1u);
    return b;
}
__device__ __forceinline__ void xcd_barrier_complete(unsigned* bar, unsigned x, unsigned& nloc, unsigned& nx) {
    const unsigned G = gridDim.x * gridDim.y * gridDim.z;
    unsigned sum, cnt, mine, sp = 0u;
    for (;;) {
        sum = 0u; cnt = 0u; mine = 0u;
#pragma unroll
        for (unsigned j = 0; j < 16; ++j) { const unsigned c = xb_ld(&bar[XB_XCNT(j)]); sum += c; cnt += (c > 0u) ? 1u : 0u; mine = (j == x) ? c : mine; }
        if (sum == G) break;
        __builtin_amdgcn_s_sleep(1);
        if ((++sp & 255u) == 0u) { if (xb_ld(&bar[XB_TMO])) break; if (sp > XB_SPIN_CAP) { atomicAdd(&bar[XB_TMO], 1u); break; } }
    }
    nloc = mine > 0u ? mine : 1u; nx = cnt > 0u ? cnt : 1u;
}
__device__ __forceinline__ void xcd_barrier(const XcdBarrier& b) {
    asm volatile("s_waitcnt vmcnt(0)" ::: "memory");
    __syncthreads();
    if (threadIdx.x == 0) {
        unsigned* bar = b.bar;
        __builtin_amdgcn_s_waitcnt(0);
        unsigned nloc = b.st[0], nx = b.st[1];
        if (nloc == 0u) { xcd_barrier_complete(bar, b.x, nloc, nx); b.st[0] = nloc; b.st[1] = nx; }
        const unsigned old = xb_add(&bar[XB_XSUB(b.x)], 1u);
        const unsigned gen = old / nloc;
        if (old + 1u == (gen + 1u) * nloc) {
            __builtin_amdgcn_fence(__ATOMIC_RELEASE, "agent");
            asm volatile("s_waitcnt vmcnt(0)" ::: "memory");
            const unsigned og = xb_add(&bar[XB_TOP], 1u);
            const unsigned tg = og / nx;
            if (og + 1u == (tg + 1u) * nx) xb_add(&bar[XB_TOPGEN], 1u);
            else XB_SPIN(xb_ld(&bar[XB_TOPGEN]) == tg, bar);
            __builtin_amdgcn_fence(__ATOMIC_ACQUIRE, "agent");
            xb_add(&bar[XB_XGEN(b.x)], 1u);
            asm volatile("s_waitcnt vmcnt(0)" ::: "memory");
        } else {
            XB_SPIN(xb_ld(&bar[XB_XGEN(b.x)]) == gen, bar);
            __builtin_amdgcn_fence(__ATOMIC_ACQUIRE, "agent");
            asm volatile("s_waitcnt vmcnt(0)" ::: "memory");
        }
    }
    __syncthreads();
}

constexpr int NG_LD = 132;
template <int NB>
__device__ __forceinline__ void ngemm_tile(float* lds, const bf16* A, int lda, long arow_src  , const float* B0, const float* B1, int ldb, int n0, int N, int K,
                                           float (&acc)[NB][8][4]) {
    const int tid = threadIdx.x;
    float* As = lds; float* Bs0 = lds + 16 * NG_LD; float* Bs1 = lds + 32 * NG_LD;
    const int ty = tid >> 5, tx = tid & 31;
    const int arow = tid >> 2, akq = (tid & 3) * 4;
    const int bk = tid >> 5, bn = (tid & 31) * 4;
    const bool bvalid = (n0 + bn) < N;
#pragma unroll
    for (int b = 0; b < NB; ++b)
#pragma unroll
        for (int i = 0; i < 8; ++i)
#pragma unroll
            for (int j = 0; j < 4; ++j) acc[b][i][j] = 0.f;
    for (int k0 = 0; k0 < K; k0 += 16) {
        u32x2 av = (u32x2){0u, 0u};
        if (arow_src >= 0) av = *(const u32x2*)(A + (size_t)arow_src * lda + k0 + akq);
        f32x4 bv0 = (f32x4){0.f, 0.f, 0.f, 0.f}, bv1 = (f32x4){0.f, 0.f, 0.f, 0.f};
        if (bvalid) { bv0 = *(const f32x4*)(B0 + (size_t)(k0 + bk) * ldb + n0 + bn); if (NB == 2) bv1 = *(const f32x4*)(B1 + (size_t)(k0 + bk) * ldb + n0 + bn); }
        __syncthreads();
        As[(akq + 0) * NG_LD + arow] = bf2f(av.x & 0xffffu); As[(akq + 1) * NG_LD + arow] = bf2f(av.x >> 16);
        As[(akq + 2) * NG_LD + arow] = bf2f(av.y & 0xffffu); As[(akq + 3) * NG_LD + arow] = bf2f(av.y >> 16);
        *(f32x4*)&Bs0[bk * NG_LD + bn] = bv0; if (NB == 2) *(f32x4*)&Bs1[bk * NG_LD + bn] = bv1;
        __syncthreads();
#pragma unroll 4
        for (int k = 0; k < 16; ++k) {
            const f32x4 a0 = *(const f32x4*)&As[k * NG_LD + ty * 8], a1 = *(const f32x4*)&As[k * NG_LD + ty * 8 + 4];
            const float a[8] = {a0.x, a0.y, a0.z, a0.w, a1.x, a1.y, a1.z, a1.w};
            const f32x4 b0 = *(const f32x4*)&Bs0[k * NG_LD + tx * 4];
#pragma unroll
            for (int i = 0; i < 8; ++i) { acc[0][i][0] += a[i] * b0.x; acc[0][i][1] += a[i] * b0.y; acc[0][i][2] += a[i] * b0.z; acc[0][i][3] += a[i] * b0.w; }
            if (NB == 2) { const f32x4 b1 = *(const f32x4*)&Bs1[k * NG_LD + tx * 4];
#pragma unroll
                for (int i = 0; i < 8; ++i) { acc[NB - 1][i][0] += a[i] * b1.x; acc[NB - 1][i][1] += a[i] * b1.y; acc[NB - 1][i][2] += a[i] * b1.z; acc[NB - 1][i][3] += a[i] * b1.w; } }
        }
    }
    __syncthreads();
}

__device__ __forceinline__ void ph0_prologue(const CParams& p) {
    const int lane = threadIdx.x & 63, wave = threadIdx.x >> 6;
    const float* x = p.in[0]; const float* nw = p.in[1]; bf16* XN = (bf16*)(p.ws + WS_XN);
    f32x4 w[4];
#pragma unroll
    for (int j = 0; j < 4; ++j) w[j] = ((const f32x4*)nw)[lane + 64 * j];
    for (int m = blockIdx.x * NWAVES + wave; m < M; m += gridDim.x * NWAVES) {
        const f32x4* xr = (const f32x4*)(x + (size_t)m * DM) + lane;
        f32x4 v[4]; float s = 0.f;
#pragma unroll
        for (int j = 0; j < 4; ++j) { v[j] = xr[64 * j]; s += (v[j].x * v[j].x + v[j].y * v[j].y) + (v[j].z * v[j].z + v[j].w * v[j].w); }
        const float rstd = rsqrtf(wave_sum(s) * (1.f / DM) + 1e-6f);
        u32x2* o = (u32x2*)(XN + (size_t)m * DM) + lane;
#pragma unroll
        for (int j = 0; j < 4; ++j) o[64 * j] = (u32x2){pk2(v[j].x * rstd * w[j].x, v[j].y * rstd * w[j].y), pk2(v[j].z * rstd * w[j].z, v[j].w * rstd * w[j].w)};
    }
}

__device__ __forceinline__ void ph1_win(const CParams& p, float* lds) {
    const int tid = threadIdx.x, ty = tid >> 5, tx = tid & 31;
    const bf16* XN = (const bf16*)(p.ws + WS_XN); const float* W = p.in[2];
    bf16* PRW = (bf16*)(p.ws + WS_PRW); bf16* PFOX = (bf16*)(p.ws + WS_PFOX);
    constexpr int NT_N = (IN_COLS + 127) / 128, NT_M = M / 128;
    for (int t = blockIdx.x; t < NT_M * NT_N; t += gridDim.x) {
        const int tm = t / NT_N, tn = t % NT_N, n0 = tn * 128;
        float acc[1][8][4];
        ngemm_tile<1>(lds, XN, DM, (long)tm * 128 + (tid >> 2), W, nullptr, IN_COLS, n0, IN_COLS, DM, acc);
        const int col = n0 + tx * 4;
        if (col < IN_COLS) {
#pragma unroll
            for (int i = 0; i < 8; ++i) {
                const size_t row = (size_t)tm * 128 + ty * 8 + i;
                const u32x2 o = (u32x2){pk2(acc[0][i][0], acc[0][i][1]), pk2(acc[0][i][2], acc[0][i][3])};
                if (col < RW_COLS) *(u32x2*)(PRW + row * RW_COLS + col) = o; else *(u32x2*)(PFOX + row * FOX_COLS + (col - RW_COLS)) = o;
            }
        }
    }
}

__device__ __forceinline__ void ph2_foxprep(const CParams& p) {
    const int lane = threadIdx.x & 63, wave = threadIdx.x >> 6;
    const bf16* PFOX = (const bf16*)(p.ws + WS_PFOX);
    bf16* QF = (bf16*)(p.ws + WS_QF); bf16* KF = (bf16*)(p.ws + WS_KF); bf16* VF = (bf16*)(p.ws + WS_VF); float* LOGF = (float*)(p.ws + WS_LOGF);
    const float qw = p.in[15][lane], kw = p.in[16][lane];
    for (int m = blockIdx.x * NWAVES + wave; m < M; m += gridDim.x * NWAVES) {
        const bf16* pr = PFOX + (size_t)m * FOX_COLS;
#pragma unroll
        for (int h = 0; h < 8; ++h) {
            const float q = bf2f(pr[h * 64 + lane]), k = bf2f(pr[512 + h * 64 + lane]);
            const float rq = rsqrtf(wave_sum(q * q) * (1.f / 64.f) + 1e-6f), rk = rsqrtf(wave_sum(k * k) * (1.f / 64.f) + 1e-6f);
            QF[(size_t)m * 512 + h * 64 + lane] = (bf16)f2bf(q * rq * qw * QSCALE);
            KF[(size_t)m * 512 + h * 64 + lane] = (bf16)f2bf(k * rk * kw);
            VF[(size_t)m * 512 + h * 64 + lane] = pr[1024 + h * 64 + lane];
        }
        if (lane < 8) { const float z = bf2f(pr[1536 + lane]) + p.in[14][lane]; LOGF[(size_t)m * 8 + lane] = -softplusf_(-z); }
    }
}

__device__ __forceinline__ void ph3_cumsum(const CParams& p, float* lds) {
    if (blockIdx.x >= 32) return;
    const int tid = threadIdx.x, b = blockIdx.x >> 3, h = blockIdx.x & 7;
    const float* LOGF = (const float*)(p.ws + WS_LOGF); float* CUMF = (float*)(p.ws + WS_CUMF);
    float v[16]; float run = 0.f;
#pragma unroll
    for (int i = 0; i < 16; ++i) { run += LOGF[((size_t)b * SEQ + tid * 16 + i) * 8 + h]; v[i] = run; }
    lds[tid] = run; __syncthreads();
    for (int off = 1; off < 512; off <<= 1) { float a = (tid >= off) ? lds[tid - off] : 0.f; __syncthreads(); lds[tid] += a; __syncthreads(); }
    const float base = lds[tid] - run;
#pragma unroll
    for (int i = 0; i < 16; ++i) CUMF[((size_t)b * SEQ + tid * 16 + i) * 8 + h] = base + v[i];
}

__device__ __forceinline__ void ph4_attn(const CParams& p, float* lds) {
    const int tid = threadIdx.x, qi = tid >> 3, sub = tid & 7;
    const bf16* QF = (const bf16*)(p.ws + WS_QF); const bf16* KF = (const bf16*)(p.ws + WS_KF); const bf16* VF = (const bf16*)(p.ws + WS_VF);
    const float* CUMF = (const float*)(p.ws + WS_CUMF); bf16* YMIX = (bf16*)(p.ws + WS_YMIX);
    float* Qs = lds; float* Ks = Qs + 64 * 68; float* Vs = Ks + 64 * 68; float* Ps = Vs + 64 * 68; float* Cs = Ps + 64 * 65;
    for (int u = blockIdx.x; u < 32 * 128; u += gridDim.x) {
        const int qblk = 127 - (u >> 5), bh = u & 31, b = bh >> 3, h = bh & 7, q0 = qblk * 64;
        const size_t rowbase = (size_t)b * SEQ;
        { const u32x4 v = *(const u32x4*)(QF + (rowbase + q0 + qi) * 512 + h * 64 + sub * 8); float* d = Qs + qi * 68 + sub * 8;
          d[0] = bf2f(v.x & 0xffffu); d[1] = bf2f(v.x >> 16); d[2] = bf2f(v.y & 0xffffu); d[3] = bf2f(v.y >> 16); d[4] = bf2f(v.z & 0xffffu); d[5] = bf2f(v.z >> 16); d[6] = bf2f(v.w & 0xffffu); d[7] = bf2f(v.w >> 16); }
        const float cq = CUMF[(rowbase + q0 + qi) * 8 + h] * LOG2E;
        float m_run = -1e30f, l_run = 0.f, o[8];
#pragma unroll
        for (int i = 0; i < 8; ++i) o[i] = 0.f;
        for (int kt = 0; kt <= qblk; ++kt) {
            __syncthreads();
            { const u32x4 kv = *(const u32x4*)(KF + (rowbase + kt * 64 + qi) * 512 + h * 64 + sub * 8); float* d = Ks + qi * 68 + sub * 8;
              d[0] = bf2f(kv.x & 0xffffu); d[1] = bf2f(kv.x >> 16); d[2] = bf2f(kv.y & 0xffffu); d[3] = bf2f(kv.y >> 16); d[4] = bf2f(kv.z & 0xffffu); d[5] = bf2f(kv.z >> 16); d[6] = bf2f(kv.w & 0xffffu); d[7] = bf2f(kv.w >> 16);
              const u32x4 vv = *(const u32x4*)(VF + (rowbase + kt * 64 + qi) * 512 + h * 64 + sub * 8); float* e = Vs + qi * 68 + sub * 8;
              e[0] = bf2f(vv.x & 0xffffu); e[1] = bf2f(vv.x >> 16); e[2] = bf2f(vv.y & 0xffffu); e[3] = bf2f(vv.y >> 16); e[4] = bf2f(vv.z & 0xffffu); e[5] = bf2f(vv.z >> 16); e[6] = bf2f(vv.w & 0xffffu); e[7] = bf2f(vv.w >> 16); }
            if (tid < 64) Cs[tid] = CUMF[(rowbase + kt * 64 + tid) * 8 + h] * LOG2E;
            __syncthreads();
            float s[8];
#pragma unroll
            for (int j = 0; j < 8; ++j) s[j] = 0.f;
#pragma unroll
            for (int d4 = 0; d4 < 16; ++d4) {
                const f32x4 q4 = *(const f32x4*)&Qs[qi * 68 + d4 * 4];
#pragma unroll
                for (int j = 0; j < 8; ++j) { const f32x4 k4 = *(const f32x4*)&Ks[(sub + 8 * j) * 68 + d4 * 4]; s[j] += (q4.x * k4.x + q4.y * k4.y) + (q4.z * k4.z + q4.w * k4.w); }
            }
            float mx = -1e30f;
#pragma unroll
            for (int j = 0; j < 8; ++j) { const int kv = kt * 64 + sub + 8 * j; s[j] += cq - Cs[sub + 8 * j]; if (kv > q0 + qi) s[j] = -INFINITY; mx = fmaxf(mx, s[j]); }
            mx = fmaxf(mx, __shfl_xor(mx, 1)); mx = fmaxf(mx, __shfl_xor(mx, 2)); mx = fmaxf(mx, __shfl_xor(mx, 4));
            const float m_new = fmaxf(m_run, mx), alpha = __builtin_amdgcn_exp2f(m_run - m_new);
            float ps = 0.f;
#pragma unroll
            for (int j = 0; j < 8; ++j) { const float pj = __builtin_amdgcn_exp2f(s[j] - m_new); ps += pj; Ps[qi * 65 + sub + 8 * j] = pj; }
            ps += __shfl_xor(ps, 1); ps += __shfl_xor(ps, 2); ps += __shfl_xor(ps, 4);
            l_run = l_run * alpha + ps; m_run = m_new;
#pragma unroll
            for (int i = 0; i < 8; ++i) o[i] *= alpha;
            __syncthreads();
#pragma unroll 8
            for (int kv = 0; kv < 64; ++kv) {
                const float pv = Ps[qi * 65 + kv]; const f32x4 v0 = *(const f32x4*)&Vs[kv * 68 + sub * 8], v1 = *(const f32x4*)&Vs[kv * 68 + sub * 8 + 4];
                o[0] += pv * v0.x; o[1] += pv * v0.y; o[2] += pv * v0.z; o[3] += pv * v0.w; o[4] += pv * v1.x; o[5] += pv * v1.y; o[6] += pv * v1.z; o[7] += pv * v1.w;
            }
        }
        const float inv = 1.f / l_run;
        *(u32x4*)(YMIX + (rowbase + q0 + qi) * DM + 512 + h * 64 + sub * 8) = (u32x4){pk2(o[0] * inv, o[1] * inv), pk2(o[2] * inv, o[3] * inv), pk2(o[4] * inv, o[5] * inv), pk2(o[6] * inv, o[7] * inv)};
    }
}

__device__ __forceinline__ float shifted(const bf16* PRW, const float* mu, size_t m, int c) {
    const float cur = bf2f(PRW[m * RW_COLS + c]);
    const float prev = ((m % SEQ) == 0) ? 0.f : bf2f(PRW[(m - 1) * RW_COLS + c]);
    return cur + (prev - cur) * mu[c];
}

__device__ __forceinline__ void ph5_rwprep(const CParams& p, float* lds) {
    const int tid = threadIdx.x, ch = tid;
    const bf16* PRW = (const bf16*)(p.ws + WS_PRW); const float* mu = p.in[3];
    float* LD = (float*)(p.ws + WS_LD); bf16* K2 = (bf16*)(p.ws + WS_K2); bf16* KK = (bf16*)(p.ws + WS_KK); bf16* BB = (bf16*)(p.ws + WS_BB); bf16* Gb = (bf16*)(p.ws + WS_G);
    const float* w0 = p.in[4]; const float* w2 = p.in[5]; const float* a0 = p.in[6]; const float* a2 = p.in[7]; const float* g2 = p.in[8];
    const float kkw = p.in[9][ch], kaw = p.in[10][ch], w0c = w0[ch], a0c = a0[ch];
    float* Xs = lds;
    for (int grp = blockIdx.x; grp < M / 8; grp += gridDim.x) {
        const size_t m0 = (size_t)grp * 8;
        __syncthreads();
#pragma unroll
        for (int i = 0; i < 4; ++i) {
            const int idx = tid * 4 + i, tk = idx >> 8, c = idx & 255;
            const int col = c < 64 ? C_PW + c : (c < 128 ? C_PA + (c - 64) : C_PG + (c - 128));
            float v = shifted(PRW, mu, m0 + tk, col);
            v = c < 64 ? tanhf(v) : (c < 128 ? v : sigmoidf_(v));
            Xs[idx] = v;
        }
        __syncthreads();
        float accw[8], acca[8], accg[8];
#pragma unroll
        for (int t = 0; t < 8; ++t) { accw[t] = 0.f; acca[t] = 0.f; accg[t] = 0.f; }
        for (int j = 0; j < 64; ++j) { const float wv = w2[j * 512 + ch], av = a2[j * 512 + ch];
#pragma unroll
            for (int t = 0; t < 8; ++t) { accw[t] += Xs[t * 256 + j] * wv; acca[t] += Xs[t * 256 + 64 + j] * av; } }
        for (int j = 0; j < 128; ++j) { const float gv = g2[j * 512 + ch];
#pragma unroll
            for (int t = 0; t < 8; ++t) accg[t] += Xs[t * 256 + 128 + j] * gv; }
#pragma unroll
        for (int t = 0; t < 8; ++t) {
            const size_t m = m0 + t;
            const float kraw = shifted(PRW, mu, m, C_K + ch);
            const float wlog = -softplusf_(-(w0c + accw[t])) - 0.5f;
            LD[m * 512 + ch] = -__expf(wlog);
            const float al = sigmoidf_(a0c + acca[t]);
            const float kkv = kraw * kkw;
            const float nrm = fmaxf(sqrtf(wave_sum(kkv * kkv)), 1e-12f);
            const float kk = kkv / nrm;
            K2[m * 512 + ch] = (bf16)f2bf(kraw * (1.f + (al - 1.f) * kaw));
            KK[m * 512 + ch] = (bf16)f2bf(kk);
            BB[m * 512 + ch] = (bf16)f2bf(kk * al);
            Gb[m * 512 + ch] = (bf16)f2bf(accg[t]);
        }
    }
}

__device__ __forceinline__ void ph6_scan(const CParams& p, float* lds) {
    if (blockIdx.x >= 32) return;
    const int tid = threadIdx.x, b = blockIdx.x >> 3, h = blockIdx.x & 7, vi = tid >> 3, q = tid & 7;
    const bf16* PRW = (const bf16*)(p.ws + WS_PRW); const float* mu = p.in[3];
    const float* LD = (const float*)(p.ws + WS_LD); const bf16* K2 = (const bf16*)(p.ws + WS_K2); const bf16* KK = (const bf16*)(p.ws + WS_KK); const bf16* BB = (const bf16*)(p.ws + WS_BB);
    float* Y = (float*)(p.ws + WS_Y);
    float* Rs = lds; float* Ws = Rs + 2048; float* Ks = Ws + 2048; float* As = Ks + 2048; float* Bs = As + 2048; float* Vs = Bs + 2048; float* Ys = Vs + 2048;
    float S[8];
#pragma unroll
    for (int j = 0; j < 8; ++j) S[j] = 0.f;
    for (int c0 = 0; c0 < SEQ; c0 += 32) {
        __syncthreads();
#pragma unroll
        for (int i = 0; i < 4; ++i) {
            const int idx = tid * 4 + i, t = idx >> 6, c = idx & 63; const size_t m = (size_t)b * SEQ + c0 + t; const int col = h * 64 + c;
            Rs[idx] = shifted(PRW, mu, m, C_R + col); Vs[idx] = shifted(PRW, mu, m, C_V + col);
            Ws[idx] = __expf(LD[m * 512 + col]); Ks[idx] = bf2f(K2[m * 512 + col]); As[idx] = -bf2f(KK[m * 512 + col]); Bs[idx] = bf2f(BB[m * 512 + col]);
        }
        __syncthreads();
        for (int t = 0; t < 32; ++t) {
            const f32x4 a0 = *(const f32x4*)&As[t * 64 + q * 8], a1 = *(const f32x4*)&As[t * 64 + q * 8 + 4];
            float sa = (S[0] * a0.x + S[1] * a0.y) + (S[2] * a0.z + S[3] * a0.w) + (S[4] * a1.x + S[5] * a1.y) + (S[6] * a1.z + S[7] * a1.w);
            sa += __shfl_xor(sa, 1); sa += __shfl_xor(sa, 2); sa += __shfl_xor(sa, 4);
            const float vv = Vs[t * 64 + vi];
            const f32x4 w0 = *(const f32x4*)&Ws[t * 64 + q * 8], w1 = *(const f32x4*)&Ws[t * 64 + q * 8 + 4];
            const f32x4 b0 = *(const f32x4*)&Bs[t * 64 + q * 8], b1 = *(const f32x4*)&Bs[t * 64 + q * 8 + 4];
            const f32x4 k0 = *(const f32x4*)&Ks[t * 64 + q * 8], k1 = *(const f32x4*)&Ks[t * 64 + q * 8 + 4];
            const f32x4 r0 = *(const f32x4*)&Rs[t * 64 + q * 8], r1 = *(const f32x4*)&Rs[t * 64 + q * 8 + 4];
            S[0] = S[0] * w0.x + sa * b0.x + vv * k0.x; S[1] = S[1] * w0.y + sa * b0.y + vv * k0.y; S[2] = S[2] * w0.z + sa * b0.z + vv * k0.z; S[3] = S[3] * w0.w + sa * b0.w + vv * k0.w;
            S[4] = S[4] * w1.x + sa * b1.x + vv * k1.x; S[5] = S[5] * w1.y + sa * b1.y + vv * k1.y; S[6] = S[6] * w1.z + sa * b1.z + vv * k1.z; S[7] = S[7] * w1.w + sa * b1.w + vv * k1.w;
            float y = (S[0] * r0.x + S[1] * r0.y) + (S[2] * r0.z + S[3] * r0.w) + (S[4] * r1.x + S[5] * r1.y) + (S[6] * r1.z + S[7] * r1.w);
            y += __shfl_xor(y, 1); y += __shfl_xor(y, 2); y += __shfl_xor(y, 4);
            if (q == 0) Ys[t * 64 + vi] = y;
        }
        __syncthreads();
#pragma unroll
        for (int i = 0; i < 4; ++i) { const int idx = tid * 4 + i, t = idx >> 6, c = idx & 63; Y[((size_t)b * SEQ + c0 + t) * 512 + h * 64 + c] = Ys[idx]; }
    }
}

__device__ __forceinline__ void ph7_rwpost(const CParams& p) {
    const int lane = threadIdx.x & 63, wave = threadIdx.x >> 6;
    const bf16* PRW = (const bf16*)(p.ws + WS_PRW); const float* mu = p.in[3];
    const float* Y = (const float*)(p.ws + WS_Y); const bf16* K2 = (const bf16*)(p.ws + WS_K2); const bf16* Gb = (const bf16*)(p.ws + WS_G); bf16* YMIX = (bf16*)(p.ws + WS_YMIX);
    for (int m = blockIdx.x * NWAVES + wave; m < M; m += gridDim.x * NWAVES) {
#pragma unroll
        for (int h = 0; h < 8; ++h) {
            const int c = h * 64 + lane;
            const float y = Y[(size_t)m * 512 + c];
            const float mean = wave_sum(y) * (1.f / 64.f), d = y - mean, var = wave_sum(d * d) * (1.f / 64.f);
            const float yn = d * rsqrtf(var + 64e-5f) * p.in[12][c] + p.in[13][c];
            const float r = shifted(PRW, mu, m, C_R + c), v = shifted(PRW, mu, m, C_V + c), k2 = bf2f(K2[(size_t)m * 512 + c]);
            const float bonus = wave_sum(r * k2 * p.in[11][c]) * v;
            YMIX[(size_t)m * DM + c] = (bf16)f2bf((yn + bonus) * bf2f(Gb[(size_t)m * 512 + c]));
        }
    }
}

__device__ __forceinline__ void ph8_wout(const CParams& p, float* lds) {
    const int tid = threadIdx.x, ty = tid >> 5, tx = tid & 31;
    const bf16* YMIX = (const bf16*)(p.ws + WS_YMIX); const float* W = p.in[17]; const float* x = p.in[0];
    for (int t = blockIdx.x; t < (M / 128) * 8; t += gridDim.x) {
        const int tm = t >> 3, tn = t & 7, n0 = tn * 128;
        float acc[1][8][4];
        ngemm_tile<1>(lds, YMIX, DM, (long)tm * 128 + (tid >> 2), W, nullptr, DM, n0, DM, DM, acc);
#pragma unroll
        for (int i = 0; i < 8; ++i) { const size_t off = ((size_t)tm * 128 + ty * 8 + i) * DM + n0 + tx * 4; const f32x4 xv = *(const f32x4*)(x + off);
            *(f32x4*)(p.out + off) = (f32x4){xv.x + acc[0][i][0], xv.y + acc[0][i][1], xv.z + acc[0][i][2], xv.w + acc[0][i][3]}; }
    }
}

__device__ __forceinline__ void ph9_route(const CParams& p, float* lds) {
    const int lane = threadIdx.x & 63, wave = threadIdx.x >> 6;
    bf16* H2 = (bf16*)(p.ws + WS_H2); int* EID = (int*)(p.ws + WS_EID); float* GATE = (float*)(p.ws + WS_GATE); int* RANK = (int*)(p.ws + WS_RANK);
    int* CNT = (int*)(p.ws + WS_CTL) + CW_CNT;
    const float* nw = p.in[18]; const float* rgw = p.in[19]; const float* rgb = p.in[20]; const float* rew = p.in[21]; const float* reb = p.in[22];
    float* Hs = lds + wave * 1024;
    f32x4 w[4];
#pragma unroll
    for (int j = 0; j < 4; ++j) w[j] = ((const f32x4*)nw)[lane + 64 * j];
    for (int grp = blockIdx.x; grp < M / 8; grp += gridDim.x) {
        const size_t m = (size_t)grp * 8 + wave;
        const f32x4* xr = (const f32x4*)(p.out + m * DM) + lane;
        f32x4 v[4]; float s = 0.f;
#pragma unroll
        for (int j = 0; j < 4; ++j) { v[j] = xr[64 * j]; s += (v[j].x * v[j].x + v[j].y * v[j].y) + (v[j].z * v[j].z + v[j].w * v[j].w); }
        const float rstd = rsqrtf(wave_sum(s) * (1.f / DM) + 1e-6f);
        __syncthreads();
#pragma unroll
        for (int j = 0; j < 4; ++j) { const f32x4 hv = (f32x4){v[j].x * rstd * w[j].x, v[j].y * rstd * w[j].y, v[j].z * rstd * w[j].z, v[j].w * rstd * w[j].w};
            *(f32x4*)&Hs[(lane + 64 * j) * 4] = hv; ((u32x2*)(H2 + m * DM))[lane + 64 * j] = (u32x2){pk2(hv.x, hv.y), pk2(hv.z, hv.w)}; }
        __syncthreads();
        float el = 0.f, gl = 0.f;
#pragma unroll 8
        for (int k = 0; k < DM; ++k) { const float hk = Hs[k]; el += hk * rew[k * 64 + lane]; gl += hk * rgw[k * 8 + (lane & 7)]; }
        el += reb[lane]; gl += rgb[lane & 7];
        float best = -INFINITY; int bi = 0;
#pragma unroll
        for (int j = 0; j < 8; ++j) { const float vj = __shfl(gl, j); if (vj > best) { best = vj; bi = j; } }
        float gs = 0.f;
#pragma unroll
        for (int j = 0; j < 8; ++j) gs += __expf(__shfl(gl, j) - best);
        const float ggate = 1.f / gs;
        float t1 = -INFINITY, t2 = -INFINITY; int i1 = 0, i2 = 0;
#pragma unroll
        for (int j = 0; j < 8; ++j) { const float vj = __shfl(el, bi * 8 + j); if (vj > t1) { t2 = t1; i2 = i1; t1 = vj; i1 = j; } else if (vj > t2) { t2 = vj; i2 = j; } }
        const float p1 = 1.f / (1.f + __expf(t2 - t1)), p2 = 1.f - p1;
        if (lane == 0) {
            const int s0 = bi * 8 + i1, s1 = 64 + bi * 8 + i2;
            EID[m * 2] = s0; EID[m * 2 + 1] = s1; GATE[m * 2] = ggate * p1; GATE[m * 2 + 1] = ggate * p2;
            RANK[m * 2] = atomicAdd(&CNT[s0], 1); RANK[m * 2 + 1] = atomicAdd(&CNT[s1], 1);
        }
    }
}

constexpr int RT = 128;
__device__ __forceinline__ int seg_table(const CParams& p, int* offs, int* cnts) {
    const int* CNT = (const int*)(p.ws + WS_CTL) + CW_CNT;
    __syncthreads();
    if (threadIdx.x < NSEG) cnts[threadIdx.x] = __hip_atomic_load(CNT + threadIdx.x, __ATOMIC_RELAXED, __HIP_MEMORY_SCOPE_AGENT);
    __syncthreads();
    if (threadIdx.x == 0) { int run = 0; for (int s = 0; s < NSEG; ++s) { offs[s] = run; run += (cnts[s] + RT - 1) / RT; } offs[NSEG] = run; }
    __syncthreads();
    return offs[NSEG];
}
__device__ __forceinline__ int seg_of_tile(const int* offs, int rt) { int s = 0; for (int k = 64; k > 0; k >>= 1) if (offs[s + k] <= rt) s += k; return s; }

__device__ __forceinline__ void ph10_lists(const CParams& p, float* lds) {
    int* offs = (int*)lds; int* cnts = offs + 160;
    seg_table(p, offs, cnts);
    const int* EID = (const int*)(p.ws + WS_EID); const float* GATE = (const float*)(p.ws + WS_GATE); const int* RANK = (const int*)(p.ws + WS_RANK);
    int* LIST = (int*)(p.ws + WS_LIST); float* LG = (float*)(p.ws + WS_LG);
    for (int a = blockIdx.x * NTHREADS + threadIdx.x; a < M * 2; a += gridDim.x * NTHREADS) {
        const int s = EID[a], pos = offs[s] * RT + RANK[a];
        LIST[pos] = a >> 1; LG[pos] = GATE[a];
    }
}

__device__ __forceinline__ void ph11_gateup(const CParams& p, float* lds) {
    const int tid = threadIdx.x, ty = tid >> 5, tx = tid & 31;
    int* offs = (int*)(lds + 48 * NG_LD); int* cnts = offs + 160;
    const int ntile = seg_table(p, offs, cnts);
    const bf16* H2 = (const bf16*)(p.ws + WS_H2); const int* LIST = (const int*)(p.ws + WS_LIST); bf16* HID = (bf16*)(p.ws + WS_HID);
    for (int t = blockIdx.x; t < ntile * 4; t += gridDim.x) {
        const int rt = t >> 2, ct = t & 3, s = seg_of_tile(offs, rt), e = s & 63, r0 = (rt - offs[s]) * RT, nvalid = cnts[s] - r0;
        const int arow = tid >> 2;
        const long src = (arow < nvalid) ? (long)LIST[rt * RT + arow] : -1;
        float acc[2][8][4];
        ngemm_tile<2>(lds, H2, DM, src, p.in[23] + (size_t)e * DM * DEXP, p.in[24] + (size_t)e * DM * DEXP, DEXP, ct * 128, DEXP, DM, acc);
#pragma unroll
        for (int i = 0; i < 8; ++i) { const int row = ty * 8 + i;
            if (row < nvalid) { float hv[4];
#pragma unroll
                for (int j = 0; j < 4; ++j) { const float g = acc[0][i][j]; hv[j] = g * sigmoidf_(g) * acc[1][i][j]; }
                *(u32x2*)(HID + ((size_t)rt * RT + row) * DEXP + ct * 128 + tx * 4) = (u32x2){pk2(hv[0], hv[1]), pk2(hv[2], hv[3])}; } }
    }
}

__device__ __forceinline__ void ph12_down(const CParams& p, float* lds) {
    const int tid = threadIdx.x, ty = tid >> 5, tx = tid & 31;
    int* offs = (int*)(lds + 48 * NG_LD); int* cnts = offs + 160;
    const int ntile = seg_table(p, offs, cnts);
    const bf16* HID = (const bf16*)(p.ws + WS_HID); const int* LIST = (const int*)(p.ws + WS_LIST); const float* LG = (const float*)(p.ws + WS_LG);
    for (int t = blockIdx.x; t < ntile * 8; t += gridDim.x) {
        const int rt = t >> 3, ct = t & 7, s = seg_of_tile(offs, rt), e = s & 63, r0 = (rt - offs[s]) * RT, nvalid = cnts[s] - r0;
        const int arow = tid >> 2;
        const long src = (arow < nvalid) ? (long)rt * RT + arow : -1;
        float acc[1][8][4];
        ngemm_tile<1>(lds, HID, DEXP, src, p.in[25] + (size_t)e * DEXP * DM, nullptr, DM, ct * 128, DM, DEXP, acc);
#pragma unroll
        for (int i = 0; i < 8; ++i) { const int row = ty * 8 + i;
            if (row < nvalid) { const int tok = LIST[rt * RT + row]; const float g = LG[rt * RT + row]; float* o = p.out + (size_t)tok * DM + ct * 128 + tx * 4;
#pragma unroll
                for (int j = 0; j < 4; ++j) atomicAdd(o + j, g * acc[0][i][j]); } }
    }
}

__global__ void __launch_bounds__(NTHREADS, 2) fwd_kernel(Params p_unused) {
    extern __shared__ __attribute__((aligned(16))) unsigned char lds_raw[];
    float* lds = (float*)lds_raw;
    const CParams* kp = (const CParams*)__builtin_amdgcn_kernarg_segment_ptr();
#define P (*kp_launder(kp))
    volatile LAS unsigned* MISC = (volatile LAS unsigned*)((LAS unsigned char*)lds_raw + LDS_BYTES - 256);
    if (threadIdx.x < 64) MISC[threadIdx.x] = 0u;
    __syncthreads();
    XcdBarrier bar; bar.bar = (unsigned*)(kp->ws + WS_CTL) + CW_BAR; bar.x = 0; bar.st = nullptr;
    if (N_LAUNCHES == 1) bar = xcd_barrier_post((unsigned*)(kp->ws + WS_CTL) + CW_BAR, MISC + 8);
    const int lo = kp->ph_lo, hi = kp->ph_hi;
#ifdef ONLY_PHASE
#define IN(k) ((k) == ONLY_PHASE && lo <= (k) && (k) < hi)
#elif defined(PHASE_MASK)
#define IN(k) (((PHASE_MASK >> (k)) & 1) && lo <= (k) && (k) < hi)
#else
#define IN(k) (lo <= (k) && (k) < hi)
#endif
#define SEAM(k) do { if (IN(k) && IN((k) + 1)) xcd_barrier(bar); } while (0)
    if (IN(0)) ph0_prologue(P);
    SEAM(0);
    if (IN(1)) ph1_win(P, lds);
    SEAM(1);
    if (IN(2)) ph2_foxprep(P);
    SEAM(2);
    if (IN(3)) ph3_cumsum(P, lds);
    SEAM(3);
    if (IN(4)) ph4_attn(P, lds);
    SEAM(4);
    if (IN(5)) ph5_rwprep(P, lds);
    SEAM(5);
    if (IN(6)) ph6_scan(P, lds);
    SEAM(6);
    if (IN(7)) ph7_rwpost(P);
    SEAM(7);
    if (IN(8)) ph8_wout(P, lds);
    SEAM(8);
    if (IN(9)) ph9_route(P, lds);
    SEAM(9);
    if (IN(10)) ph10_lists(P, lds);
    SEAM(10);
    if (IN(11)) ph11_gateup(P, lds);
    SEAM(11);
    if (IN(12)) ph12_down(P, lds);
#undef IN
#undef SEAM
#undef P
}

extern "C" void kernel_launch(void* const* d_in, const int* in_sizes, int n_in, void* d_out, int out_size, void* d_ws, size_t ws_size, hipStream_t stream) {
    static int grid = 0;
    if (grid == 0) {
        if (n_in != 26 || in_sizes[0] != M * DM || out_size != M * DM || ws_size < WS_END) { fprintf(stderr, "kernel_launch: unexpected shapes / workspace (n_in %d, ws %zu)\n", n_in, ws_size); grid = -1; return; }
        int dev = 0, cus = 0, per_cu = 0;
        if (hipGetDevice(&dev) != hipSuccess || hipDeviceGetAttribute(&cus, hipDeviceAttributeMultiprocessorCount, dev) != hipSuccess) { grid = -1; return; }
        if (hipFuncSetAttribute((const void*)fwd_kernel, hipFuncAttributeMaxDynamicSharedMemorySize, LDS_BYTES) != hipSuccess) { fprintf(stderr, "kernel_launch: hipFuncSetAttribute failed\n"); grid = -1; return; }
        if (hipOccupancyMaxActiveBlocksPerMultiprocessor(&per_cu, (const void*)fwd_kernel, NTHREADS, LDS_BYTES) != hipSuccess || per_cu < 1) { fprintf(stderr, "kernel_launch: occupancy query failed (%d)\n", per_cu); (void)hipGetLastError(); per_cu = 1; }
        grid = cus * per_cu;
    }
    if (grid < 0) return;
    (void)hipMemsetAsync((char*)d_ws + WS_CTL, 0, CTL_ZERO_BYTES, stream);
    Params a{};
    for (int i = 0; i < 26; ++i) a.in[i] = (const float*)d_in[i];
    a.out = (float*)d_out; a.ws = (unsigned char*)d_ws;
    if (N_LAUNCHES == 1) {
        a.ph_lo = 0; a.ph_hi = NPHASE; a.li = 0;
        void* args[] = {&a};
        hipError_t e = hipLaunchCooperativeKernel((const void*)fwd_kernel, dim3(grid), dim3(NTHREADS), args, LDS_BYTES, stream);
        if (e != hipSuccess) fprintf(stderr, "kernel_launch: cooperative launch failed: %s (grid %d)\n", hipGetErrorString(e), grid);
    } else {
        for (int li = 0; li < NPHASE; ++li) {
            a.ph_lo = li; a.ph_hi = li + 1; a.li = li;
            hipLaunchKernelGGL(fwd_kernel, dim3(grid), dim3(NTHREADS), LDS_BYTES, stream, a);
        }
    }
}
```

```cpp
#include <hip/hip_runtime.h>
#include <cstdio>
#include <cstdint>

#ifndef MK_N_LAUNCHES
#define MK_N_LAUNCHES 1
#endif

#define GAS __attribute__((address_space(1)))
#define LAS __attribute__((address_space(3)))
typedef unsigned short bf16;
typedef float f32x4 __attribute__((ext_vector_type(4)));
typedef unsigned u32x4 __attribute__((ext_vector_type(4)));
typedef unsigned u32x2 __attribute__((ext_vector_type(2)));

constexpr int BATCH = 4, SEQ = 8192, DM = 1024, M = BATCH * SEQ;
constexpr int RW_COLS = 1792, FOX_COLS = 1544, IN_COLS = 3336;
constexpr int C_R = 0, C_PW = 512, C_K = 576, C_V = 1088, C_PA = 1600, C_PG = 1664;
constexpr int NEXP = 64, DEXP = 512, NSEG = 128;
constexpr float LOG2E = 1.4426950408889634f;
constexpr float QSCALE = 0.125f * LOG2E;
constexpr int NWAVES = 8, NTHREADS = 512;
constexpr int NPHASE = 13;
constexpr int N_LAUNCHES = MK_N_LAUNCHES;
constexpr int LDS_BYTES = 147456;

constexpr size_t MiB = 1u << 20;
constexpr size_t WS_CTL = 0, CTL_ZERO_BYTES = 1 * MiB;
constexpr size_t WS_WINT = 2 * MiB;
constexpr size_t WS_WOUTT = 10 * MiB;
constexpr size_t WS_LOGF = 13 * MiB, WS_CUMF = 14 * MiB;
constexpr size_t WS_XN = 16 * MiB;
constexpr size_t WS_YMIX = 16 * MiB;
constexpr size_t WS_H2 = 16 * MiB;
constexpr size_t WS_PRW = 80 * MiB;
constexpr size_t WS_QF = 192 * MiB, WS_KF = 224 * MiB, WS_VF = 256 * MiB;
constexpr size_t WS_Y = 192 * MiB;
constexpr size_t WS_G = 256 * MiB;
constexpr size_t WS_LD = 288 * MiB;
constexpr size_t WS_K2 = 352 * MiB, WS_KK = 384 * MiB, WS_BB = 416 * MiB;
constexpr size_t WS_HID = 288 * MiB;
constexpr size_t WS_EWGU = 80 * MiB;
constexpr size_t WS_EWD = 208 * MiB;
constexpr size_t WS_EID = 448 * MiB;
constexpr size_t WS_GATE = WS_EID + 256 * 1024, WS_RANK = WS_GATE + 256 * 1024, WS_LIST = WS_RANK + 256 * 1024, WS_LG = WS_LIST + 512 * 1024;
constexpr size_t WS_END = 452 * MiB;
constexpr int CW_CNT = 64;
constexpr int CW_BAR = 4096;
constexpr int NWIN = 3328;

struct Params {
    const float* in[26];
    float* out;
    unsigned char* ws;
    int ph_lo, ph_hi, li, pad;
};
#define CAS __attribute__((address_space(4)))
typedef CAS Params CParams;
__device__ __forceinline__ const CParams* kp_launder(const CParams* q) { asm volatile("" : "+s"(q)); return q; }

__device__ __forceinline__ float bf2f(unsigned u) { return __uint_as_float(u << 16); }
__device__ __forceinline__ unsigned f2bf(float f) { unsigned u = __float_as_uint(f); return (u + 0x7fffu + ((u >> 16) & 1u)) >> 16; }
__device__ __forceinline__ unsigned pk2(float lo, float hi) { return f2bf(lo) | (f2bf(hi) << 16); }
__device__ __forceinline__ float wave_sum(float v) {
#pragma unroll
    for (int o = 1; o < 64; o <<= 1) v += __shfl_xor(v, o);
    return v;
}
__device__ __forceinline__ float sigmoidf_(float x) { return 1.0f / (1.0f + __expf(-x)); }
__device__ __forceinline__ float softplusf_(float z) { return fmaxf(z, 0.f) + log1pf(__expf(-fabsf(z))); }

#define XB_TMO      128
#define XB_XCNT(j)  (256  + 64 * (j))
#define XB_XSUB(j)  (1280 + 64 * (j))
#define XB_XGEN(j)  (2304 + 64 * (j))
#define XB_TOP      3328
#define XB_TOPGEN   3392
#define XCD_BAR_WORDS 3456
#define XB_SPIN_CAP (1u << 22)
__device__ __forceinline__ unsigned xb_ld(unsigned* p)              { return __hip_atomic_load(p, __ATOMIC_RELAXED, __HIP_MEMORY_SCOPE_AGENT); }
__device__ __forceinline__ unsigned xb_add(unsigned* p, unsigned v) { return __hip_atomic_fetch_add(p, v, __ATOMIC_RELAXED, __HIP_MEMORY_SCOPE_AGENT); }
__device__ __forceinline__ unsigned xb_xcc_id() { return (unsigned)__builtin_amdgcn_s_getreg((3 << 11) | 20) & 0xFu; }
#define XB_SPIN(cond, bar) do { unsigned _sp = 0; while (cond) { __builtin_amdgcn_s_sleep(1); \
    if ((++_sp & 255u) == 0u) { if (xb_ld(&(bar)[XB_TMO])) break; if (_sp > XB_SPIN_CAP) { atomicAdd(&(bar)[XB_TMO], 1u); break; } } } } while (0)
struct XcdBarrier { unsigned* bar; unsigned x; volatile LAS unsigned* st; };
__device__ __forceinline__ XcdBarrier xcd_barrier_post(unsigned* bar, volatile LAS unsigned* st) {
    XcdBarrier b; b.bar = bar; b.x = xb_xcc_id(); b.st = st;
    if (threadIdx.x == 0) (void)xb_add(&bar[XB_XCNT(b.x)], 1u);
    return b;
}
__device__ __forceinline__ void xcd_barrier_complete(unsigned* bar, unsigned x, unsigned& nloc, unsigned& nx) {
    const unsigned G = gridDim.x * gridDim.y * gridDim.z;
    unsigned sum, cnt, mine, sp = 0u;
    for (;;) {
        sum = 0u; cnt = 0u; mine = 0u;
#pragma unroll
        for (unsigned j = 0; j < 16; ++j) { const unsigned c = xb_ld(&bar[XB_XCNT(j)]); sum += c; cnt += (c > 0u) ? 1u : 0u; mine = (j == x) ? c : mine; }
        if (sum == G) break;
        __builtin_amdgcn_s_sleep(1);
        if ((++sp & 255u) == 0u) { if (xb_ld(&bar[XB_TMO])) break; if (sp > XB_SPIN_CAP) { atomicAdd(&bar[XB_TMO], 1u); break; } }
    }
    nloc = mine > 0u ? mine : 1u; nx = cnt > 0u ? cnt : 1u;
}
__device__ __forceinline__ void xcd_barrier(const XcdBarrier& b) {
    asm volatile("s_waitcnt vmcnt(0)" ::: "memory");
    __syncthreads();
    if (threadIdx.x == 0) {
        unsigned* bar = b.bar;
        __builtin_amdgcn_s_waitcnt(0);
        unsigned nloc = b.st[0], nx = b.st[1];
        if (nloc == 0u) { xcd_barrier_complete(bar, b.x, nloc, nx); b.st[0] = nloc; b.st[1] = nx; }
        const unsigned old = xb_add(&bar[XB_XSUB(b.x)], 1u);
        const unsigned gen = old / nloc;
        if (old + 1u == (gen + 1u) * nloc) {
            __builtin_amdgcn_fence(__ATOMIC_RELEASE, "agent");
            asm volatile("s_waitcnt vmcnt(0)" ::: "memory");
            const unsigned og = xb_add(&bar[XB_TOP], 1u);
            const unsigned tg = og / nx;
            if (og + 1u == (tg + 1u) * nx) xb_add(&bar[XB_TOPGEN], 1u);
            else XB_SPIN(xb_ld(&bar[XB_TOPGEN]) == tg, bar);
            __builtin_amdgcn_fence(__ATOMIC_ACQUIRE, "agent");
            xb_add(&bar[XB_XGEN(b.x)], 1u);
            asm volatile("s_waitcnt vmcnt(0)" ::: "memory");
        } else {
            XB_SPIN(xb_ld(&bar[XB_XGEN(b.x)]) == gen, bar);
            __builtin_amdgcn_fence(__ATOMIC_ACQUIRE, "agent");
            asm volatile("s_waitcnt vmcnt(0)" ::: "memory");
        }
    }
    __syncthreads();
}

constexpr int NG_LD = 132;
template <int NB>
__device__ __forceinline__ void ngemm_tile(float* lds, const bf16* A, int lda, long arow_src  , const float* B0, const float* B1, int ldb, int n0, int N, int K,
                                           float (&acc)[NB][8][4]) {
    const int tid = threadIdx.x;
    float* As = lds; float* Bs0 = lds + 16 * NG_LD; float* Bs1 = lds + 32 * NG_LD;
    const int ty = tid >> 5, tx = tid & 31;
    const int arow = tid >> 2, akq = (tid & 3) * 4;
    const int bk = tid >> 5, bn = (tid & 31) * 4;
    const bool bvalid = (n0 + bn) < N;
#pragma unroll
    for (int b = 0; b < NB; ++b)
#pragma unroll
        for (int i = 0; i < 8; ++i)
#pragma unroll
            for (int j = 0; j < 4; ++j) acc[b][i][j] = 0.f;
    for (int k0 = 0; k0 < K; k0 += 16) {
        u32x2 av = (u32x2){0u, 0u};
        if (arow_src >= 0) av = *(const u32x2*)(A + (size_t)arow_src * lda + k0 + akq);
        f32x4 bv0 = (f32x4){0.f, 0.f, 0.f, 0.f}, bv1 = (f32x4){0.f, 0.f, 0.f, 0.f};
        if (bvalid) { bv0 = *(const f32x4*)(B0 + (size_t)(k0 + bk) * ldb + n0 + bn); if (NB == 2) bv1 = *(const f32x4*)(B1 + (size_t)(k0 + bk) * ldb + n0 + bn); }
        __syncthreads();
        As[(akq + 0) * NG_LD + arow] = bf2f(av.x & 0xffffu); As[(akq + 1) * NG_LD + arow] = bf2f(av.x >> 16);
        As[(akq + 2) * NG_LD + arow] = bf2f(av.y & 0xffffu); As[(akq + 3) * NG_LD + arow] = bf2f(av.y >> 16);
        *(f32x4*)&Bs0[bk * NG_LD + bn] = bv0; if (NB == 2) *(f32x4*)&Bs1[bk * NG_LD + bn] = bv1;
        __syncthreads();
#pragma unroll 4
        for (int k = 0; k < 16; ++k) {
            const f32x4 a0 = *(const f32x4*)&As[k * NG_LD + ty * 8], a1 = *(const f32x4*)&As[k * NG_LD + ty * 8 + 4];
            const float a[8] = {a0.x, a0.y, a0.z, a0.w, a1.x, a1.y, a1.z, a1.w};
            const f32x4 b0 = *(const f32x4*)&Bs0[k * NG_LD + tx * 4];
#pragma unroll
            for (int i = 0; i < 8; ++i) { acc[0][i][0] += a[i] * b0.x; acc[0][i][1] += a[i] * b0.y; acc[0][i][2] += a[i] * b0.z; acc[0][i][3] += a[i] * b0.w; }
            if (NB == 2) { const f32x4 b1 = *(const f32x4*)&Bs1[k * NG_LD + tx * 4];
#pragma unroll
                for (int i = 0; i < 8; ++i) { acc[NB - 1][i][0] += a[i] * b1.x; acc[NB - 1][i][1] += a[i] * b1.y; acc[NB - 1][i][2] += a[i] * b1.z; acc[NB - 1][i][3] += a[i] * b1.w; } }
        }
    }
    __syncthreads();
}

namespace pg8 {
typedef short bf16x8 __attribute__((ext_vector_type(8)));
constexpr int BM = 256, BK = 64, HALF = 128, HTB = HALF * BK * 2, STAGE_BYTES = 8 * HTB, NXCD = 8;
__host__ __device__ __forceinline__ int lds_byte(int r, int c) { const int st = (r >> 4) * 2 + (c >> 5), rr = r & 15, cc = c & 31, ob = rr * 64 + cc * 2; return st * 1024 + (ob ^ (((ob >> 9) & 1) << 5)); }
__host__ __device__ __forceinline__ void stage_rc(int b, int& R, int& C) { const int st = b / 1024, sb = b % 1024, swz = sb ^ (((sb >> 9) & 1) << 5); R = (st >> 1) * 16 + swz / 64; C = (st & 1) * 32 + (swz % 64) / 2; }
__host__ __device__ __forceinline__ int perm32(int rho) { const int n = rho >> 4, i = rho & 15; return 8 * (i >> 2) + 4 * n + (i & 3); }
struct Unit { int arow; int pm, pn; int nvalid; int seg; unsigned boff_lo, boff_hi; };
__device__ __forceinline__ size_t unit_boff(const Unit& u) { return ((size_t)u.boff_hi << 32) | u.boff_lo; }
__device__ __forceinline__ void set_boff(Unit& u, size_t b) { u.boff_lo = (unsigned)b; u.boff_hi = (unsigned)(b >> 32); }
__device__ __forceinline__ unsigned cvt_pk_bf16(float lo, float hi) { unsigned r; asm volatile("v_cvt_pk_bf16_f32 %0, %1, %2" : "=v"(r) : "v"(lo), "v"(hi)); return r; }

struct DenseOrder {
    int nM, nN, nwg, G, c, K;
    __device__ void init(int M_, int N_, int K_, int G_, int c_) { nM = M_ / BM; nN = N_ / BM; nwg = nM * nN; G = G_; c = c_; K = K_; }
    __device__ bool next(int i, Unit& u) const {
        const long L = (long)i * G + c; if (L >= nwg) return false;
        int wgid = (int)L; { const int q = nwg / NXCD, r = nwg % NXCD, xcd = wgid % NXCD, off = wgid / NXCD; wgid = (xcd < r ? xcd * (q + 1) : r * (q + 1) + (xcd - r) * q) + off; }
        const int WGM = 8, nig = WGM * nN, gid = wgid / nig, fm = gid * WGM, gsz = (nM - fm) < WGM ? (nM - fm) : WGM;
        u.pm = fm + ((wgid % nig) % gsz); u.pn = (wgid % nig) / gsz; u.arow = u.pm * BM; u.nvalid = BM; u.seg = 0; set_boff(u, (size_t)u.pn * BM * K * 2);
        return true;
    }
};

template <class Epi, class Sched, bool ALIGN_EPI, bool GATHER>
__device__ __forceinline__ void gemm_phase(LAS unsigned char* lds, const bf16* A, const bf16* Bt, const int K, const int* list, const Sched& S, const Epi& E) {
    const int tid = threadIdx.x, wid = __builtin_amdgcn_readfirstlane(tid >> 6), lane = tid & 63, wr = wid >> 2, wc = wid & 3, fr = lane & 15, fq = lane >> 4;
    const int nt = K / BK;
    int Rr[2], Cc[2]; unsigned voffB[2];
#pragma unroll
    for (int i = 0; i < 2; ++i) { int R, C; stage_rc(tid * 16 + i * 8192, R, C); Rr[i] = R; Cc[i] = C; const int Rb = Epi::PERM ? ((R & ~31) + perm32(R & 31)) : R; voffB[i] = (unsigned)(Rb * K + C) * 2u; }
    const size_t kstep = (size_t)(BK * 2);
    const size_t hstepB = (size_t)HALF * K * 2;
    const unsigned ldsw = (unsigned)wid * 1024u;
    const int aoff = lds_byte(wr * 64 + fr, fq * 8), boff = lds_byte(wc * 32 + fr, fq * 8);
#define PG8_SA(b, h) (((b) * 2 + (h)) * HTB)
#define PG8_SB(b, h) ((4 + (b) * 2 + (h)) * HTB)
#define PG8_STAGE_A(bufoff, gbase, VO) do { _Pragma("unroll") for (int _i = 0; _i < 2; ++_i) \
        __builtin_amdgcn_global_load_lds((const unsigned*)((const char*)(gbase) + (VO)[_i]), (LAS unsigned*)(lds + (bufoff) + ldsw + _i * 8192), 16, 0, 0); } while (0)
#define PG8_STAGE_B(bufoff, gbase) do { _Pragma("unroll") for (int _i = 0; _i < 2; ++_i) \
        __builtin_amdgcn_global_load_lds((const unsigned*)((const char*)(gbase) + voffB[_i]), (LAS unsigned*)(lds + (bufoff) + ldsw + _i * 8192), 16, 0, 0); } while (0)
#define PG8_LDA(dst, b, h) do { _Pragma("unroll") for (int m = 0; m < 4; ++m) _Pragma("unroll") for (int k = 0; k < 2; ++k) dst[m][k] = *(const LAS bf16x8*)(lds + PG8_SA(b, h) + aoff + m * 2048 + k * 1024); } while (0)
#define PG8_LDB(dst, b, h) do { _Pragma("unroll") for (int n = 0; n < 2; ++n) _Pragma("unroll") for (int k = 0; k < 2; ++k) dst[n][k] = *(const LAS bf16x8*)(lds + PG8_SB(b, h) + boff + n * 2048 + k * 1024); } while (0)
#define PG8_MMA(ai, bj, At, Bt_) do { __builtin_amdgcn_s_setprio(1); _Pragma("unroll") for (int m = 0; m < 4; ++m) _Pragma("unroll") for (int n = 0; n < 2; ++n) _Pragma("unroll") for (int k = 0; k < 2; ++k) \
        acc[ai][bj][m][n] = __builtin_amdgcn_mfma_f32_16x16x32_bf16(Bt_[n][k], At[m][k], acc[ai][bj][m][n], 0, 0, 0); __builtin_amdgcn_s_setprio(0); } while (0)
#define PG8_WAIT_V(n) asm volatile("s_waitcnt vmcnt(" #n ")" ::: "memory")
#define PG8_WAIT_L(n) asm volatile("s_waitcnt lgkmcnt(" #n ")" ::: "memory")
#define PG8_BAR __builtin_amdgcn_s_barrier()
#define PG8_SCHED __builtin_amdgcn_sched_barrier(0)
#define PG8_MKVO(u, vo) do { _Pragma("unroll") for (int _h = 0; _h < 2; ++_h) _Pragma("unroll") for (int _i = 0; _i < 2; ++_i) { const int _row = _h * HALF + Rr[_i]; \
        const int _src = GATHER ? list[(u).arow + (_row < (u).nvalid ? _row : 0)] : (u).arow + _row; vo[_h][_i] = (unsigned)(_src * K + Cc[_i]) * 2u; } } while (0)
    Unit cur, nxt; int ui = 0;
    if (!S.next(0, cur)) return;
    unsigned cvo[2][2], nvo[2][2];
    PG8_MKVO(cur, cvo);
#pragma unroll
    for (int _h = 0; _h < 2; ++_h) { nvo[_h][0] = cvo[_h][0]; nvo[_h][1] = cvo[_h][1]; }
    f32x4 acc[2][2][4][2];
#pragma unroll
    for (int a = 0; a < 2; ++a)
#pragma unroll
        for (int b = 0; b < 2; ++b)
#pragma unroll
            for (int m = 0; m < 4; ++m)
#pragma unroll
                for (int n = 0; n < 2; ++n) acc[a][b][m][n] = (f32x4){0.f, 0.f, 0.f, 0.f};
    bf16x8 At[4][2], B0[2][2], B1[2][2];
    const char* const Ab = (const char*)A;
    const char* cB = (const char*)Bt + unit_boff(cur);
    PG8_STAGE_B(PG8_SB(0, 0), cB); PG8_STAGE_B(PG8_SB(0, 1), cB + hstepB); PG8_STAGE_A(PG8_SA(0, 0), Ab, cvo[0]); PG8_STAGE_A(PG8_SA(0, 1), Ab, cvo[1]);
    if (wr == 1) PG8_BAR;
    PG8_WAIT_V(2); PG8_BAR;
    PG8_STAGE_B(PG8_SB(1, 0), cB + kstep); PG8_STAGE_A(PG8_SA(1, 0), Ab + kstep, cvo[0]); PG8_STAGE_B(PG8_SB(1, 1), cB + hstepB + kstep);
    PG8_WAIT_V(6); PG8_BAR;
    for (;;) {
        const bool has_next = S.next(ui + 1, nxt);
        if (has_next) PG8_MKVO(nxt, nvo);
        const char* nB = has_next ? (const char*)Bt + unit_boff(nxt) : cB;
        for (int t = 0; t < nt; t += 2) {
            const bool last = (t == nt - 2), usen = last && has_next;
            const char* a1 = Ab + (size_t)(t + 1) * kstep;
            const char* a2 = last ? Ab : Ab + (size_t)(t + 2) * kstep; const char* b2 = last ? nB : cB + (size_t)(t + 2) * kstep;
            const char* a3 = a2 + kstep; const char* b3 = b2 + kstep;
            unsigned s0[2], s1[2];
            s0[0] = usen ? nvo[0][0] : cvo[0][0]; s0[1] = usen ? nvo[0][1] : cvo[0][1]; s1[0] = usen ? nvo[1][0] : cvo[1][0]; s1[1] = usen ? nvo[1][1] : cvo[1][1];
            PG8_LDB(B0, 0, 0); PG8_LDB(B1, 0, 1); PG8_SCHED; PG8_LDA(At, 0, 0); PG8_STAGE_A(PG8_SA(1, 1), a1, cvo[1]);
            PG8_WAIT_V(8); PG8_WAIT_L(0); PG8_BAR; PG8_MMA(0, 0, At, B0); PG8_MMA(0, 1, At, B1); PG8_BAR; PG8_SCHED;
            PG8_LDA(At, 0, 1); PG8_STAGE_B(PG8_SB(0, 0), b2); PG8_STAGE_B(PG8_SB(0, 1), b2 + hstepB); PG8_STAGE_A(PG8_SA(0, 0), a2, s0);
            PG8_WAIT_V(8); PG8_WAIT_L(0); PG8_BAR; PG8_MMA(1, 0, At, B0); PG8_MMA(1, 1, At, B1); PG8_BAR; PG8_SCHED;
            PG8_LDB(B0, 1, 0); PG8_LDB(B1, 1, 1); PG8_SCHED; PG8_LDA(At, 1, 0); PG8_STAGE_A(PG8_SA(0, 1), a2, s1);
            PG8_WAIT_V(8); PG8_WAIT_L(0); PG8_BAR; PG8_MMA(0, 0, At, B0); PG8_MMA(0, 1, At, B1); PG8_BAR; PG8_SCHED;
            PG8_LDA(At, 1, 1); PG8_STAGE_B(PG8_SB(1, 0), b3); PG8_STAGE_B(PG8_SB(1, 1), b3 + hstepB); PG8_STAGE_A(PG8_SA(1, 0), a3, s0);
            PG8_WAIT_V(8); PG8_WAIT_L(0); PG8_BAR; PG8_MMA(1, 0, At, B0); PG8_MMA(1, 1, At, B1); PG8_BAR; PG8_SCHED;
        }
        if constexpr (ALIGN_EPI) { if (wr == 0) PG8_BAR; }
        E(acc, cur, wr, wc, fr, fq, lds);
        if (!has_next) break;
#pragma unroll
        for (int a = 0; a < 2; ++a)
#pragma unroll
            for (int b = 0; b < 2; ++b)
#pragma unroll
                for (int m = 0; m < 4; ++m)
#pragma unroll
                    for (int n = 0; n < 2; ++n) acc[a][b][m][n] = (f32x4){0.f, 0.f, 0.f, 0.f};
        cur = nxt; cB = nB; ++ui;
#pragma unroll
        for (int _h = 0; _h < 2; ++_h) { cvo[_h][0] = nvo[_h][0]; cvo[_h][1] = nvo[_h][1]; }
        if constexpr (ALIGN_EPI) { if (wr == 1) PG8_BAR; }
    }
    PG8_WAIT_V(0);
    if constexpr (!ALIGN_EPI) { if (wr == 0) PG8_BAR; }
    PG8_BAR;
#undef PG8_SA
#undef PG8_SB
#undef PG8_STAGE_A
#undef PG8_STAGE_B
#undef PG8_LDA
#undef PG8_LDB
#undef PG8_MMA
#undef PG8_WAIT_V
#undef PG8_WAIT_L
#undef PG8_BAR
#undef PG8_SCHED
#undef PG8_MKVO
}
}

__device__ __forceinline__ void transpose_item(const float* W, int pitch, int K, bf16* WT, int wt_row, int k0, int n0, LAS float* scr, int lane) {
#pragma unroll 8
    for (int i = 0; i < 32; ++i) { const int kk = 2 * i + (lane >> 5); scr[kk * 33 + (lane & 31)] = W[(size_t)(k0 + kk) * pitch + n0 + (lane & 31)]; }
    asm volatile("s_waitcnt lgkmcnt(0)" ::: "memory");
    const int c = lane & 7;
#pragma unroll
    for (int j = 0; j < 4; ++j) { const int n = (lane >> 3) + 8 * j; const LAS float* t = scr + (8 * c) * 33 + n;
        u32x4 o; o.x = pk2(t[0 * 33], t[1 * 33]); o.y = pk2(t[2 * 33], t[3 * 33]); o.z = pk2(t[4 * 33], t[5 * 33]); o.w = pk2(t[6 * 33], t[7 * 33]);
        *(u32x4*)(WT + (size_t)(wt_row + n) * K + k0 + 8 * c) = o; }
    asm volatile("s_waitcnt lgkmcnt(0)" ::: "memory");
}

__device__ __forceinline__ void ph0_prologue(const CParams& p, LAS unsigned char* ldsb) {
    const int lane = threadIdx.x & 63, wave = __builtin_amdgcn_readfirstlane(threadIdx.x >> 6);
    const float* x = p.in[0]; const float* nw = p.in[1]; const float* win = p.in[2]; bf16* XN = (bf16*)(p.ws + WS_XN); float* LOGF = (float*)(p.ws + WS_LOGF);
    LAS float* scr = (LAS float*)(ldsb + wave * 8704);
    LAS float* Wf = (LAS float*)(ldsb + 73728);
    for (int i = threadIdx.x; i < 8192; i += NTHREADS) Wf[i] = win[(size_t)(i >> 3) * IN_COLS + NWIN + (i & 7)];
    const int gw = blockIdx.x * NWAVES + wave, NGW = gridDim.x * NWAVES;
    constexpr int I_IN = 16 * (NWIN / 32), I_OUT = 16 * 32;
    for (int it = gw; it < I_IN + I_OUT; it += NGW) {
        if (it < I_IN) { const int kb = it / (NWIN / 32), nb = it % (NWIN / 32); transpose_item(win, IN_COLS, DM, (bf16*)(p.ws + WS_WINT), nb * 32, kb * 64, nb * 32, scr, lane); }
        else { const int r = it - I_IN, kb = r >> 5, nb = r & 31; transpose_item(p.in[17], DM, DM, (bf16*)(p.ws + WS_WOUTT), nb * 32, kb * 64, nb * 32, scr, lane); }
    }
    __syncthreads();
    f32x4 w[4];
#pragma unroll
    for (int j = 0; j < 4; ++j) w[j] = ((const f32x4*)nw)[lane + 64 * j];
    const float bfl = p.in[14][lane & 7];
    for (int m = gw; m < M; m += NGW) {
        const f32x4* xr = (const f32x4*)(x + (size_t)m * DM) + lane;
        f32x4 v[4]; float s = 0.f;
#pragma unroll
        for (int j = 0; j < 4; ++j) { v[j] = xr[64 * j]; s += (v[j].x * v[j].x + v[j].y * v[j].y) + (v[j].z * v[j].z + v[j].w * v[j].w); }
        const float rstd = rsqrtf(wave_sum(s) * (1.f / DM) + 1e-6f);
        u32x2* o = (u32x2*)(XN + (size_t)m * DM) + lane;
        float fl[8];
#pragma unroll
        for (int e = 0; e < 8; ++e) fl[e] = 0.f;
#pragma unroll
        for (int j = 0; j < 4; ++j) {
            const float h0 = v[j].x * rstd * w[j].x, h1 = v[j].y * rstd * w[j].y, h2 = v[j].z * rstd * w[j].z, h3 = v[j].w * rstd * w[j].w;
            o[64 * j] = (u32x2){pk2(h0, h1), pk2(h2, h3)};
            const float hh[4] = {h0, h1, h2, h3};
#pragma unroll
            for (int c = 0; c < 4; ++c) { const LAS f32x4* wr_ = (const LAS f32x4*)(Wf + ((lane + 64 * j) * 4 + c) * 8); const f32x4 a = wr_[0], b = wr_[1];
                fl[0] += hh[c] * a.x; fl[1] += hh[c] * a.y; fl[2] += hh[c] * a.z; fl[3] += hh[c] * a.w; fl[4] += hh[c] * b.x; fl[5] += hh[c] * b.y; fl[6] += hh[c] * b.z; fl[7] += hh[c] * b.w; }
        }
        float mine = 0.f;
#pragma unroll
        for (int e = 0; e < 8; ++e) { const float t = wave_sum(fl[e]); if ((lane & 7) == e) mine = t; }
        if (lane < 8) LOGF[(size_t)m * 8 + lane] = -softplusf_(-(mine + bfl));
    }
}

struct EpiWin {
    static constexpr bool PERM = true;
    bf16* PRW; bf16* QF; bf16* KF; bf16* VF; const float* qw; const float* kw;
    __device__ __forceinline__ void operator()(const f32x4 (&acc)[2][2][4][2], const pg8::Unit& u, int wr, int wc, int fr, int fq, LAS unsigned char* lds) const {
        const int row0 = u.pm * 256 + wr * 64 + fr, cw = wc * 32 + 8 * fq;
        if (u.pn < 7 || u.pn >= 11) {
            bf16* base = u.pn < 7 ? PRW + u.pn * 256 : VF + (u.pn - 11) * 256; const int ldc = u.pn < 7 ? RW_COLS : 512;
#pragma unroll
            for (int ai = 0; ai < 2; ++ai)
#pragma unroll
                for (int m = 0; m < 4; ++m) { bf16* rowp = base + (size_t)(row0 + ai * 128 + m * 16) * ldc + cw;
#pragma unroll
                    for (int bj = 0; bj < 2; ++bj) { const f32x4 v0 = acc[ai][bj][m][0], v1 = acc[ai][bj][m][1];
                        *(u32x4*)(rowp + bj * 128) = (u32x4){pg8::cvt_pk_bf16(v0[0], v0[1]), pg8::cvt_pk_bf16(v0[2], v0[3]), pg8::cvt_pk_bf16(v1[0], v1[1]), pg8::cvt_pk_bf16(v1[2], v1[3])}; } }
        } else {
            const bool isq = u.pn < 9; bf16* O = (isq ? QF : KF) + ((u.pn - 7) & 1) * 256; const float* wsrc = (isq ? qw : kw) + 32 * (wc & 1) + 8 * fq; const float sc = isq ? QSCALE : 1.f;
            LAS float* ex = (LAS float*)(lds + 131072);
#pragma unroll
            for (int ai = 0; ai < 2; ++ai)
#pragma unroll
                for (int bj = 0; bj < 2; ++bj)
#pragma unroll
                    for (int m = 0; m < 4; ++m) { const f32x4 v0 = acc[ai][bj][m][0], v1 = acc[ai][bj][m][1];
                        float ss = (v0[0] * v0[0] + v0[1] * v0[1]) + (v0[2] * v0[2] + v0[3] * v0[3]) + (v1[0] * v1[0] + v1[1] * v1[1]) + (v1[2] * v1[2] + v1[3] * v1[3]);
                        ss += __shfl_xor(ss, 16); ss += __shfl_xor(ss, 32);
                        if (fq == 0) ex[((ai * 128 + wr * 64 + m * 16 + fr) * 4 + 2 * bj + (wc >> 1)) * 2 + (wc & 1)] = ss; }
            asm volatile("s_waitcnt lgkmcnt(0)\n\ts_barrier" ::: "memory");
            float wv[8];
#pragma unroll
            for (int j = 0; j < 8; ++j) wv[j] = wsrc[j] * sc;
#pragma unroll
            for (int ai = 0; ai < 2; ++ai)
#pragma unroll
                for (int m = 0; m < 4; ++m) { bf16* rowp = O + (size_t)(row0 + ai * 128 + m * 16) * 512 + cw;
#pragma unroll
                    for (int bj = 0; bj < 2; ++bj) { const LAS float* e2 = ex + ((ai * 128 + wr * 64 + m * 16 + fr) * 4 + 2 * bj + (wc >> 1)) * 2;
                        const float rs = rsqrtf((e2[0] + e2[1]) * (1.f / 64.f) + 1e-6f); const f32x4 v0 = acc[ai][bj][m][0], v1 = acc[ai][bj][m][1];
                        *(u32x4*)(rowp + bj * 128) = (u32x4){pg8::cvt_pk_bf16(v0[0] * rs * wv[0], v0[1] * rs * wv[1]), pg8::cvt_pk_bf16(v0[2] * rs * wv[2], v0[3] * rs * wv[3]),
                                                             pg8::cvt_pk_bf16(v1[0] * rs * wv[4], v1[1] * rs * wv[5]), pg8::cvt_pk_bf16(v1[2] * rs * wv[6], v1[3] * rs * wv[7])}; } }
        }
    }
};
__device__ __forceinline__ void ph1_win(const CParams& p, LAS unsigned char* ldsb) {
    pg8::DenseOrder S; S.init(M, NWIN, DM, gridDim.x, blockIdx.x);
    EpiWin E{(bf16*)(p.ws + WS_PRW), (bf16*)(p.ws + WS_QF), (bf16*)(p.ws + WS_KF), (bf16*)(p.ws + WS_VF), p.in[15], p.in[16]};
    pg8::gemm_phase<EpiWin, pg8::DenseOrder, true, false>(ldsb, (const bf16*)(p.ws + WS_XN), (const bf16*)(p.ws + WS_WINT), DM, nullptr, S, E);
}

__device__ __forceinline__ void ph3_cumsum(const CParams& p, float* lds) {
    if (blockIdx.x >= 32) return;
    const int tid = threadIdx.x, b = blockIdx.x >> 3, h = blockIdx.x & 7;
    const float* LOGF = (const float*)(p.ws + WS_LOGF); float* CUMF = (float*)(p.ws + WS_CUMF);
    float v[16]; float run = 0.f;
#pragma unroll
    for (int i = 0; i < 16; ++i) { run += LOGF[((size_t)b * SEQ + tid * 16 + i) * 8 + h]; v[i] = run; }
    lds[tid] = run; __syncthreads();
    for (int off = 1; off < 512; off <<= 1) { float a = (tid >= off) ? lds[tid - off] : 0.f; __syncthreads(); lds[tid] += a; __syncthreads(); }
    const float base = lds[tid] - run;
#pragma unroll
    for (int i = 0; i < 16; ++i) CUMF[((size_t)b * SEQ + tid * 16 + i) * 8 + h] = base + v[i];
}

__device__ __forceinline__ void ph4_attn(const CParams& p, float* lds) {
    const int tid = threadIdx.x, qi = tid >> 3, sub = tid & 7;
    const bf16* QF = (const bf16*)(p.ws + WS_QF); const bf16* KF = (const bf16*)(p.ws + WS_KF); const bf16* VF = (const bf16*)(p.ws + WS_VF);
    const float* CUMF = (const float*)(p.ws + WS_CUMF); bf16* YMIX = (bf16*)(p.ws + WS_YMIX);
    float* Qs = lds; float* Ks = Qs + 64 * 68; float* Vs = Ks + 64 * 68; float* Ps = Vs + 64 * 68; float* Cs = Ps + 64 * 65;
    for (int u = blockIdx.x; u < 32 * 128; u += gridDim.x) {
        const int qblk = 127 - (u >> 5), bh = u & 31, b = bh >> 3, h = bh & 7, q0 = qblk * 64;
        const size_t rowbase = (size_t)b * SEQ;
        { const u32x4 v = *(const u32x4*)(QF + (rowbase + q0 + qi) * 512 + h * 64 + sub * 8); float* d = Qs + qi * 68 + sub * 8;
          d[0] = bf2f(v.x & 0xffffu); d[1] = bf2f(v.x >> 16); d[2] = bf2f(v.y & 0xffffu); d[3] = bf2f(v.y >> 16); d[4] = bf2f(v.z & 0xffffu); d[5] = bf2f(v.z >> 16); d[6] = bf2f(v.w & 0xffffu); d[7] = bf2f(v.w >> 16); }
        const float cq = CUMF[(rowbase + q0 + qi) * 8 + h] * LOG2E;
        float m_run = -1e30f, l_run = 0.f, o[8];
#pragma unroll
        for (int i = 0; i < 8; ++i) o[i] = 0.f;
        for (int kt = 0; kt <= qblk; ++kt) {
            __syncthreads();
            { const u32x4 kv = *(const u32x4*)(KF + (rowbase + kt * 64 + qi) * 512 + h * 64 + sub * 8); float* d = Ks + qi * 68 + sub * 8;
              d[0] = bf2f(kv.x & 0xffffu); d[1] = bf2f(kv.x >> 16); d[2] = bf2f(kv.y & 0xffffu); d[3] = bf2f(kv.y >> 16); d[4] = bf2f(kv.z & 0xffffu); d[5] = bf2f(kv.z >> 16); d[6] = bf2f(kv.w & 0xffffu); d[7] = bf2f(kv.w >> 16);
              const u32x4 vv = *(const u32x4*)(VF + (rowbase + kt * 64 + qi) * 512 + h * 64 + sub * 8); float* e = Vs + qi * 68 + sub * 8;
              e[0] = bf2f(vv.x & 0xffffu); e[1] = bf2f(vv.x >> 16); e[2] = bf2f(vv.y & 0xffffu); e[3] = bf2f(vv.y >> 16); e[4] = bf2f(vv.z & 0xffffu); e[5] = bf2f(vv.z >> 16); e[6] = bf2f(vv.w & 0xffffu); e[7] = bf2f(vv.w >> 16); }
            if (tid < 64) Cs[tid] = CUMF[(rowbase + kt * 64 + tid) * 8 + h] * LOG2E;
            __syncthreads();
            float s[8];
#pragma unroll
            for (int j = 0; j < 8; ++j) s[j] = 0.f;
#pragma unroll
            for (int d4 = 0; d4 < 16; ++d4) {
                const f32x4 q4 = *(const f32x4*)&Qs[qi * 68 + d4 * 4];
#pragma unroll
                for (int j = 0; j < 8; ++j) { const f32x4 k4 = *(const f32x4*)&Ks[(sub + 8 * j) * 68 + d4 * 4]; s[j] += (q4.x * k4.x + q4.y * k4.y) + (q4.z * k4.z + q4.w * k4.w); }
            }
            float mx = -1e30f;
#pragma unroll
            for (int j = 0; j < 8; ++j) { const int kv = kt * 64 + sub + 8 * j; s[j] += cq - Cs[sub + 8 * j]; if (kv > q0 + qi) s[j] = -INFINITY; mx = fmaxf(mx, s[j]); }
            mx = fmaxf(mx, __shfl_xor(mx, 1)); mx = fmaxf(mx, __shfl_xor(mx, 2)); mx = fmaxf(mx, __shfl_xor(mx, 4));
            const float m_new = fmaxf(m_run, mx), alpha = __builtin_amdgcn_exp2f(m_run - m_new);
            float ps = 0.f;
#pragma unroll
            for (int j = 0; j < 8; ++j) { const float pj = __builtin_amdgcn_exp2f(s[j] - m_new); ps += pj; Ps[qi * 65 + sub + 8 * j] = pj; }
            ps += __shfl_xor(ps, 1); ps += __shfl_xor(ps, 2); ps += __shfl_xor(ps, 4);
            l_run = l_run * alpha + ps; m_run = m_new;
#pragma unroll
            for (int i = 0; i < 8; ++i) o[i] *= alpha;
            __syncthreads();
#pragma unroll 8
            for (int kv = 0; kv < 64; ++kv) {
                const float pv = Ps[qi * 65 + kv]; const f32x4 v0 = *(const f32x4*)&Vs[kv * 68 + sub * 8], v1 = *(const f32x4*)&Vs[kv * 68 + sub * 8 + 4];
                o[0] += pv * v0.x; o[1] += pv * v0.y; o[2] += pv * v0.z; o[3] += pv * v0.w; o[4] += pv * v1.x; o[5] += pv * v1.y; o[6] += pv * v1.z; o[7] += pv * v1.w;
            }
        }
        const float inv = 1.f / l_run;
        *(u32x4*)(YMIX + (rowbase + q0 + qi) * DM + 512 + h * 64 + sub * 8) = (u32x4){pk2(o[0] * inv, o[1] * inv), pk2(o[2] * inv, o[3] * inv), pk2(o[4] * inv, o[5] * inv), pk2(o[6] * inv, o[7] * inv)};
    }
}

__device__ __forceinline__ float shifted(const bf16* PRW, const float* mu, size_t m, int c) {
    const float cur = bf2f(PRW[m * RW_COLS + c]);
    const float prev = ((m % SEQ) == 0) ? 0.f : bf2f(PRW[(m - 1) * RW_COLS + c]);
    return cur + (prev - cur) * mu[c];
}

__device__ __forceinline__ void ph5_rwprep(const CParams& p, float* lds) {
    const int tid = threadIdx.x, ch = tid;
    const bf16* PRW = (const bf16*)(p.ws + WS_PRW); const float* mu = p.in[3];
    float* LD = (float*)(p.ws + WS_LD); bf16* K2 = (bf16*)(p.ws + WS_K2); bf16* KK = (bf16*)(p.ws + WS_KK); bf16* BB = (bf16*)(p.ws + WS_BB); bf16* Gb = (bf16*)(p.ws + WS_G);
    const float* w0 = p.in[4]; const float* w2 = p.in[5]; const float* a0 = p.in[6]; const float* a2 = p.in[7]; const float* g2 = p.in[8];
    const float kkw = p.in[9][ch], kaw = p.in[10][ch], w0c = w0[ch], a0c = a0[ch];
    float* Xs = lds;
    for (int grp = blockIdx.x; grp < M / 8; grp += gridDim.x) {
        const size_t m0 = (size_t)grp * 8;
        __syncthreads();
#pragma unroll
        for (int i = 0; i < 4; ++i) {
            const int idx = tid * 4 + i, tk = idx >> 8, c = idx & 255;
            const int col = c < 64 ? C_PW + c : (c < 128 ? C_PA + (c - 64) : C_PG + (c - 128));
            float v = shifted(PRW, mu, m0 + tk, col);
            v = c < 64 ? tanhf(v) : (c < 128 ? v : sigmoidf_(v));
            Xs[idx] = v;
        }
        __syncthreads();
        float accw[8], acca[8], accg[8];
#pragma unroll
        for (int t = 0; t < 8; ++t) { accw[t] = 0.f; acca[t] = 0.f; accg[t] = 0.f; }
        for (int j = 0; j < 64; ++j) { const float wv = w2[j * 512 + ch], av = a2[j * 512 + ch];
#pragma unroll
            for (int t = 0; t < 8; ++t) { accw[t] += Xs[t * 256 + j] * wv; acca[t] += Xs[t * 256 + 64 + j] * av; } }
        for (int j = 0; j < 128; ++j) { const float gv = g2[j * 512 + ch];
#pragma unroll
            for (int t = 0; t < 8; ++t) accg[t] += Xs[t * 256 + 128 + j] * gv; }
#pragma unroll
        for (int t = 0; t < 8; ++t) {
            const size_t m = m0 + t;
            const float kraw = shifted(PRW, mu, m, C_K + ch);
            const float wlog = -softplusf_(-(w0c + accw[t])) - 0.5f;
            LD[m * 512 + ch] = -__expf(wlog);
            const float al = sigmoidf_(a0c + acca[t]);
            const float kkv = kraw * kkw;
            const float nrm = fmaxf(sqrtf(wave_sum(kkv * kkv)), 1e-12f);
            const float kk = kkv / nrm;
            K2[m * 512 + ch] = (bf16)f2bf(kraw * (1.f + (al - 1.f) * kaw));
            KK[m * 512 + ch] = (bf16)f2bf(kk);
            BB[m * 512 + ch] = (bf16)f2bf(kk * al);
            Gb[m * 512 + ch] = (bf16)f2bf(accg[t]);
        }
    }
}

__device__ __forceinline__ void ph6_scan(const CParams& p, float* lds) {
    if (blockIdx.x >= 32) return;
    const int tid = threadIdx.x, b = blockIdx.x >> 3, h = blockIdx.x & 7, vi = tid >> 3, q = tid & 7;
    const bf16* PRW = (const bf16*)(p.ws + WS_PRW); const float* mu = p.in[3];
    const float* LD = (const float*)(p.ws + WS_LD); const bf16* K2 = (const bf16*)(p.ws + WS_K2); const bf16* KK = (const bf16*)(p.ws + WS_KK); const bf16* BB = (const bf16*)(p.ws + WS_BB);
    float* Y = (float*)(p.ws + WS_Y);
    float* Rs = lds; float* Ws = Rs + 2048; float* Ks = Ws + 2048; float* As = Ks + 2048; float* Bs = As + 2048; float* Vs = Bs + 2048; float* Ys = Vs + 2048;
    float S[8];
#pragma unroll
    for (int j = 0; j < 8; ++j) S[j] = 0.f;
    for (int c0 = 0; c0 < SEQ; c0 += 32) {
        __syncthreads();
#pragma unroll
        for (int i = 0; i < 4; ++i) {
            const int idx = tid * 4 + i, t = idx >> 6, c = idx & 63; const size_t m = (size_t)b * SEQ + c0 + t; const int col = h * 64 + c;
            Rs[idx] = shifted(PRW, mu, m, C_R + col); Vs[idx] = shifted(PRW, mu, m, C_V + col);
            Ws[idx] = __expf(LD[m * 512 + col]); Ks[idx] = bf2f(K2[m * 512 + col]); As[idx] = -bf2f(KK[m * 512 + col]); Bs[idx] = bf2f(BB[m * 512 + col]);
        }
        __syncthreads();
        for (int t = 0; t < 32; ++t) {
            const f32x4 a0 = *(const f32x4*)&As[t * 64 + q * 8], a1 = *(const f32x4*)&As[t * 64 + q * 8 + 4];
            float sa = (S[0] * a0.x + S[1] * a0.y) + (S[2] * a0.z + S[3] * a0.w) + (S[4] * a1.x + S[5] * a1.y) + (S[6] * a1.z + S[7] * a1.w);
            sa += __shfl_xor(sa, 1); sa += __shfl_xor(sa, 2); sa += __shfl_xor(sa, 4);
            const float vv = Vs[t * 64 + vi];
            const f32x4 w0 = *(const f32x4*)&Ws[t * 64 + q * 8], w1 = *(const f32x4*)&Ws[t * 64 + q * 8 + 4];
            const f32x4 b0 = *(const f32x4*)&Bs[t * 64 + q * 8], b1 = *(const f32x4*)&Bs[t * 64 + q * 8 + 4];
            const f32x4 k0 = *(const f32x4*)&Ks[t * 64 + q * 8], k1 = *(const f32x4*)&Ks[t * 64 + q * 8 + 4];
            const f32x4 r0 = *(const f32x4*)&Rs[t * 64 + q * 8], r1 = *(const f32x4*)&Rs[t * 64 + q * 8 + 4];
            S[0] = S[0] * w0.x + sa * b0.x + vv * k0.x; S[1] = S[1] * w0.y + sa * b0.y + vv * k0.y; S[2] = S[2] * w0.z + sa * b0.z + vv * k0.z; S[3] = S[3] * w0.w + sa * b0.w + vv * k0.w;
            S[4] = S[4] * w1.x + sa * b1.x + vv * k1.x; S[5] = S[5] * w1.y + sa * b1.y + vv * k1.y; S[6] = S[6] * w1.z + sa * b1.z + vv * k1.z; S[7] = S[7] * w1.w + sa * b1.w + vv * k1.w;
            float y = (S[0] * r0.x + S[1] * r0.y) + (S[2] * r0.z + S[3] * r0.w) + (S[4] * r1.x + S[5] * r1.y) + (S[6] * r1.z + S[7] * r1.w);
            y += __shfl_xor(y, 1); y += __shfl_xor(y, 2); y += __shfl_xor(y, 4);
            if (q == 0) Ys[t * 64 + vi] = y;
        }
        __syncthreads();
#pragma unroll
        for (int i = 0; i < 4; ++i) { const int idx = tid * 4 + i, t = idx >> 6, c = idx & 63; Y[((size_t)b * SEQ + c0 + t) * 512 + h * 64 + c] = Ys[idx]; }
    }
}

__device__ __forceinline__ void ph7_rwpost(const CParams& p) {
    const int lane = threadIdx.x & 63, wave = threadIdx.x >> 6;
    const bf16* PRW = (const bf16*)(p.ws + WS_PRW); const float* mu = p.in[3];
    const float* Y = (const float*)(p.ws + WS_Y); const bf16* K2 = (const bf16*)(p.ws + WS_K2); const bf16* Gb = (const bf16*)(p.ws + WS_G); bf16* YMIX = (bf16*)(p.ws + WS_YMIX);
    for (int m = blockIdx.x * NWAVES + wave; m < M; m += gridDim.x * NWAVES) {
#pragma unroll
        for (int h = 0; h < 8; ++h) {
            const int c = h * 64 + lane;
            const float y = Y[(size_t)m * 512 + c];
            const float mean = wave_sum(y) * (1.f / 64.f), d = y - mean, var = wave_sum(d * d) * (1.f / 64.f);
            const float yn = d * rsqrtf(var + 64e-5f) * p.in[12][c] + p.in[13][c];
            const float r = shifted(PRW, mu, m, C_R + c), v = shifted(PRW, mu, m, C_V + c), k2 = bf2f(K2[(size_t)m * 512 + c]);
            const float bonus = wave_sum(r * k2 * p.in[11][c]) * v;
            YMIX[(size_t)m * DM + c] = (bf16)f2bf((yn + bonus) * bf2f(Gb[(size_t)m * 512 + c]));
        }
    }
}

struct EpiRes {
    static constexpr bool PERM = false;
    const float* x; float* out;
    __device__ __forceinline__ void operator()(const f32x4 (&acc)[2][2][4][2], const pg8::Unit& u, int wr, int wc, int fr, int fq, LAS unsigned char* lds) const {
        const int col0 = u.pn * 256 + wc * 32 + 4 * fq;
#pragma unroll
        for (int ai = 0; ai < 2; ++ai)
#pragma unroll
            for (int m = 0; m < 4; ++m) { const size_t off = (size_t)(u.pm * 256 + ai * 128 + wr * 64 + m * 16 + fr) * DM + col0;
#pragma unroll
                for (int bj = 0; bj < 2; ++bj)
#pragma unroll
                    for (int n = 0; n < 2; ++n) { const f32x4 xv = *(const f32x4*)(x + off + bj * 128 + n * 16); *(f32x4*)(out + off + bj * 128 + n * 16) = xv + acc[ai][bj][m][n]; } }
    }
};
__device__ __forceinline__ void ph8_wout(const CParams& p, LAS unsigned char* ldsb) {
    pg8::DenseOrder S; S.init(M, DM, DM, gridDim.x, blockIdx.x);
    EpiRes E{p.in[0], p.out};
    pg8::gemm_phase<EpiRes, pg8::DenseOrder, true, false>(ldsb, (const bf16*)(p.ws + WS_YMIX), (const bf16*)(p.ws + WS_WOUTT), DM, nullptr, S, E);
}

__device__ __forceinline__ void ph9_route(const CParams& p, float* lds) {
    const int lane = threadIdx.x & 63, wave = threadIdx.x >> 6;
    bf16* H2 = (bf16*)(p.ws + WS_H2); int* EID = (int*)(p.ws + WS_EID); float* GATE = (float*)(p.ws + WS_GATE); int* RANK = (int*)(p.ws + WS_RANK);
    int* CNT = (int*)(p.ws + WS_CTL) + CW_CNT;
    const float* nw = p.in[18]; const float* rgw = p.in[19]; const float* rgb = p.in[20]; const float* rew = p.in[21]; const float* reb = p.in[22];
    float* Hs = lds + wave * 1024;
    f32x4 w[4];
#pragma unroll
    for (int j = 0; j < 4; ++j) w[j] = ((const f32x4*)nw)[lane + 64 * j];
    for (int grp = blockIdx.x; grp < M / 8; grp += gridDim.x) {
        const size_t m = (size_t)grp * 8 + wave;
        const f32x4* xr = (const f32x4*)(p.out + m * DM) + lane;
        f32x4 v[4]; float s = 0.f;
#pragma unroll
        for (int j = 0; j < 4; ++j) { v[j] = xr[64 * j]; s += (v[j].x * v[j].x + v[j].y * v[j].y) + (v[j].z * v[j].z + v[j].w * v[j].w); }
        const float rstd = rsqrtf(wave_sum(s) * (1.f / DM) + 1e-6f);
        __syncthreads();
#pragma unroll
        for (int j = 0; j < 4; ++j) { const f32x4 hv = (f32x4){v[j].x * rstd * w[j].x, v[j].y * rstd * w[j].y, v[j].z * rstd * w[j].z, v[j].w * rstd * w[j].w};
            *(f32x4*)&Hs[(lane + 64 * j) * 4] = hv; ((u32x2*)(H2 + m * DM))[lane + 64 * j] = (u32x2){pk2(hv.x, hv.y), pk2(hv.z, hv.w)}; }
        __syncthreads();
        float el = 0.f, gl = 0.f;
#pragma unroll 8
        for (int k = 0; k < DM; ++k) { const float hk = Hs[k]; el += hk * rew[k * 64 + lane]; gl += hk * rgw[k * 8 + (lane & 7)]; }
        el += reb[lane]; gl += rgb[lane & 7];
        float best = -INFINITY; int bi = 0;
#pragma unroll
        for (int j = 0; j < 8; ++j) { const float vj = __shfl(gl, j); if (vj > best) { best = vj; bi = j; } }
        float gs = 0.f;
#pragma unroll
        for (int j = 0; j < 8; ++j) gs += __expf(__shfl(gl, j) - best);
        const float ggate = 1.f / gs;
        float t1 = -INFINITY, t2 = -INFINITY; int i1 = 0, i2 = 0;
#pragma unroll
        for (int j = 0; j < 8; ++j) { const float vj = __shfl(el, bi * 8 + j); if (vj > t1) { t2 = t1; i2 = i1; t1 = vj; i1 = j; } else if (vj > t2) { t2 = vj; i2 = j; } }
        const float p1 = 1.f / (1.f + __expf(t2 - t1)), p2 = 1.f - p1;
        if (lane == 0) {
            const int s0 = bi * 8 + i1, s1 = 64 + bi * 8 + i2;
            EID[m * 2] = s0; EID[m * 2 + 1] = s1; GATE[m * 2] = ggate * p1; GATE[m * 2 + 1] = ggate * p2;
            RANK[m * 2] = atomicAdd(&CNT[s0], 1); RANK[m * 2 + 1] = atomicAdd(&CNT[s1], 1);
        }
    }
}

constexpr int RT = 256;
__device__ __forceinline__ int seg_table(const CParams& p, int* offs, int* cnts) {
    const int* CNT = (const int*)(p.ws + WS_CTL) + CW_CNT;
    __syncthreads();
    if (threadIdx.x < NSEG) cnts[threadIdx.x] = __hip_atomic_load(CNT + threadIdx.x, __ATOMIC_RELAXED, __HIP_MEMORY_SCOPE_AGENT);
    __syncthreads();
    if (threadIdx.x == 0) { int run = 0; for (int s = 0; s < NSEG; ++s) { offs[s] = run; run += (cnts[s] + RT - 1) / RT; } offs[NSEG] = run; }
    __syncthreads();
    return offs[NSEG];
}
__device__ __forceinline__ int seg_of_tile(const int* offs, int rt) { int s = 0; for (int k = 64; k > 0; k >>= 1) if (offs[s + k] <= rt) s += k; return s; }

__device__ __forceinline__ void ph10_lists(const CParams& p, float* lds) {
    int* offs = (int*)lds; int* cnts = offs + 160;
    seg_table(p, offs, cnts);
    const int* EID = (const int*)(p.ws + WS_EID); const float* GATE = (const float*)(p.ws + WS_GATE); const int* RANK = (const int*)(p.ws + WS_RANK);
    int* LIST = (int*)(p.ws + WS_LIST); float* LG = (float*)(p.ws + WS_LG);
    for (int a = blockIdx.x * NTHREADS + threadIdx.x; a < M * 2; a += gridDim.x * NTHREADS) {
        const int s = EID[a], pos = offs[s] * RT + RANK[a];
        LIST[pos] = a >> 1; LG[pos] = GATE[a];
    }
}

__device__ __forceinline__ void convert_experts(const CParams& p, LAS unsigned char* ldsb) {
    const int lane = threadIdx.x & 63, wave = __builtin_amdgcn_readfirstlane(threadIdx.x >> 6);
    LAS float* scr = (LAS float*)(ldsb + wave * 8704);
    const int gw = blockIdx.x * NWAVES + wave, NGW = gridDim.x * NWAVES;
    bf16* EWGU = (bf16*)(p.ws + WS_EWGU); bf16* EWD = (bf16*)(p.ws + WS_EWD);
    for (int it = gw; it < NEXP * 768; it += NGW) {
        const int e = it / 768, r = it % 768, which = r >> 8, q = r & 255;
        if (which < 2) { const int kb = q >> 4, nb = q & 15, n0 = nb * 32;
            transpose_item(p.in[23 + which] + (size_t)e * DM * DEXP, DEXP, DM, EWGU + (size_t)e * 1024 * 1024, 256 * (n0 >> 7) + (n0 & 127) + 128 * which, kb * 64, n0, scr, lane); }
        else { const int kb = q >> 5, nb = q & 31;
            transpose_item(p.in[25] + (size_t)e * DEXP * DM, DM, DEXP, EWD + (size_t)e * 1024 * 512, nb * 32, kb * 64, nb * 32, scr, lane); }
    }
}

__device__ __forceinline__ int seg_of_tile_l(const LAS int* offs, int rt) { int s = 0;
#pragma unroll
    for (int k = 64; k > 0; k >>= 1) if (offs[s + k] <= rt) s += k; return s; }
struct GroupedOrder {
    const LAS int* offs; const LAS int* cnts; int G, c, K, t_lo, t_hi;
    __device__ __forceinline__ bool next(int i, pg8::Unit& u) const {
        const int L = i * G + c; if (L >= (t_hi - t_lo) * 4) return false;
        const int Lg = L + 4 * t_lo, s = seg_of_tile_l(offs, Lg >> 2), o = offs[s], Ts = offs[s + 1] - o, idx = Lg - 4 * o, pn = idx / Ts, rt = o + idx % Ts;
        u.pm = __builtin_amdgcn_readfirstlane(rt); u.pn = __builtin_amdgcn_readfirstlane(pn); u.arow = u.pm * 256; u.seg = __builtin_amdgcn_readfirstlane(s);
        int nv = cnts[s] - (rt - o) * 256; nv = nv > 256 ? 256 : nv; u.nvalid = __builtin_amdgcn_readfirstlane(nv);
        pg8::set_boff(u, ((size_t)(u.seg & 63) * 1024 + (size_t)u.pn * 256) * (size_t)K * 2);
        return true;
    }
};
__device__ __forceinline__ void seg_table_l(const CParams& p, LAS int* offs, LAS int* cnts) {
    const int* CNT = (const int*)(p.ws + WS_CTL) + CW_CNT;
    __syncthreads();
    if (threadIdx.x < NSEG) cnts[threadIdx.x] = __hip_atomic_load(CNT + threadIdx.x, __ATOMIC_RELAXED, __HIP_MEMORY_SCOPE_AGENT);
    __syncthreads();
    if (threadIdx.x == 0) { int run = 0; for (int s = 0; s < NSEG; ++s) { offs[s] = run; run += (cnts[s] + RT - 1) / RT; } offs[NSEG] = run; }
    __syncthreads();
}

struct EpiGateUp {
    static constexpr bool PERM = true;
    bf16* HID;
    __device__ __forceinline__ void operator()(const f32x4 (&acc)[2][2][4][2], const pg8::Unit& u, int wr, int wc, int fr, int fq, LAS unsigned char* lds) const {
#pragma unroll
        for (int ai = 0; ai < 2; ++ai)
#pragma unroll
            for (int m = 0; m < 4; ++m) { float hv[8];
#pragma unroll
                for (int n = 0; n < 2; ++n)
#pragma unroll
                    for (int i = 0; i < 4; ++i) { const float g = acc[ai][0][m][n][i]; hv[n * 4 + i] = g * acc[ai][1][m][n][i] * __builtin_amdgcn_rcpf(1.f + __expf(-g)); }
                *(u32x4*)(HID + (size_t)(u.arow + ai * 128 + wr * 64 + m * 16 + fr) * DEXP + u.pn * 128 + wc * 32 + 8 * fq) =
                    (u32x4){pg8::cvt_pk_bf16(hv[0], hv[1]), pg8::cvt_pk_bf16(hv[2], hv[3]), pg8::cvt_pk_bf16(hv[4], hv[5]), pg8::cvt_pk_bf16(hv[6], hv[7])}; }
    }
};
__device__ __forceinline__ void ph11_gateup(const CParams& p, LAS unsigned char* ldsb) {
    LAS int* offs = (LAS int*)(ldsb + 139264); LAS int* cnts = offs + 160;
    seg_table_l(p, offs, cnts);
    GroupedOrder S{offs, cnts, (int)gridDim.x, (int)((blockIdx.x % 8) * (gridDim.x / 8) + blockIdx.x / 8), DM, 0, offs[NSEG]};
    EpiGateUp E{(bf16*)(p.ws + WS_HID)};
    pg8::gemm_phase<EpiGateUp, GroupedOrder, true, true>(ldsb, (const bf16*)(p.ws + WS_H2), (const bf16*)(p.ws + WS_EWGU), DM, (const int*)(p.ws + WS_LIST), S, E);
}

struct EpiDown {
    static constexpr bool PERM = false;
    float* out; const int* LIST; const float* LG;
    __device__ __forceinline__ void operator()(const f32x4 (&acc)[2][2][4][2], const pg8::Unit& u, int wr, int wc, int fr, int fq, LAS unsigned char* lds) const {
        const int col0 = u.pn * 256 + wc * 32 + 4 * fq;
#pragma unroll
        for (int ai = 0; ai < 2; ++ai)
#pragma unroll
            for (int m = 0; m < 4; ++m) { const int rl = ai * 128 + wr * 64 + m * 16 + fr;
                if (rl < u.nvalid) { const int tok = LIST[u.arow + rl]; const float g = LG[u.arow + rl]; float* o = out + (size_t)tok * DM + col0;
#pragma unroll
                    for (int bj = 0; bj < 2; ++bj)
#pragma unroll
                        for (int n = 0; n < 2; ++n) { const f32x4 xv = *(const f32x4*)(o + bj * 128 + n * 16); *(f32x4*)(o + bj * 128 + n * 16) = xv + acc[ai][bj][m][n] * g; } } }
    }
};
__device__ __forceinline__ void ph12_down(const CParams& p, LAS unsigned char* ldsb, int pass) {
    LAS int* offs = (LAS int*)(ldsb + 139264); LAS int* cnts = offs + 160;
    seg_table_l(p, offs, cnts);
    GroupedOrder S{offs, cnts, (int)gridDim.x, (int)((blockIdx.x % 8) * (gridDim.x / 8) + blockIdx.x / 8), DEXP, offs[64 * pass], offs[64 * pass + 64]};
    EpiDown E{p.out, (const int*)(p.ws + WS_LIST), (const float*)(p.ws + WS_LG)};
    pg8::gemm_phase<EpiDown, GroupedOrder, true, false>(ldsb, (const bf16*)(p.ws + WS_HID), (const bf16*)(p.ws + WS_EWD), DEXP, nullptr, S, E);
}

__global__ void __launch_bounds__(NTHREADS, 2) fwd_kernel(Params p_unused) {
    extern __shared__ __attribute__((aligned(16))) unsigned char lds_raw[];
    float* lds = (float*)lds_raw;
    const CParams* kp = (const CParams*)__builtin_amdgcn_kernarg_segment_ptr();
#define P (*kp_launder(kp))
    volatile LAS unsigned* MISC = (volatile LAS unsigned*)((LAS unsigned char*)lds_raw + LDS_BYTES - 256);
    if (threadIdx.x < 64) MISC[threadIdx.x] = 0u;
    __syncthreads();
    XcdBarrier bar; bar.bar = (unsigned*)(kp->ws + WS_CTL) + CW_BAR; bar.x = 0; bar.st = nullptr;
    if (N_LAUNCHES == 1) bar = xcd_barrier_post((unsigned*)(kp->ws + WS_CTL) + CW_BAR, MISC + 8);
    const int lo = kp->ph_lo, hi = kp->ph_hi;
#ifdef ONLY_PHASE
#define IN(k) ((k) == ONLY_PHASE && lo <= (k) && (k) < hi)
#elif defined(PHASE_MASK)
#define IN(k) (((PHASE_MASK >> (k)) & 1) && lo <= (k) && (k) < hi)
#else
#define IN(k) (lo <= (k) && (k) < hi)
#endif
#define SEAM(k) do { if (IN(k) && IN((k) + 1)) xcd_barrier(bar); } while (0)
    LAS unsigned char* ldsb = (LAS unsigned char*)lds_raw;
    if (IN(0)) ph0_prologue(P, ldsb);
    SEAM(0);
    if (IN(1)) ph1_win(P, ldsb);
    SEAM(1);
    if (IN(2)) ph3_cumsum(P, lds);
    SEAM(2);
    if (IN(3)) ph4_attn(P, lds);
    SEAM(3);
    if (IN(4)) ph5_rwprep(P, lds);
    SEAM(4);
    if (IN(5)) ph6_scan(P, lds);
    SEAM(5);
    if (IN(6)) ph7_rwpost(P);
    SEAM(6);
    if (IN(7)) { ph8_wout(P, ldsb); convert_experts(P, ldsb); }
    SEAM(7);
    if (IN(8)) ph9_route(P, lds);
    SEAM(8);
    if (IN(9)) ph10_lists(P, lds);
    SEAM(9);
    if (IN(10)) ph11_gateup(P, ldsb);
    SEAM(10);
    if (IN(11)) ph12_down(P, ldsb, 0);
    SEAM(11);
    if (IN(12)) ph12_down(P, ldsb, 1);
#undef IN
#undef SEAM
#undef P
}

extern "C" void kernel_launch(void* const* d_in, const int* in_sizes, int n_in, void* d_out, int out_size, void* d_ws, size_t ws_size, hipStream_t stream) {
    static int grid = 0;
    if (grid == 0) {
        if (n_in != 26 || in_sizes[0] != M * DM || out_size != M * DM || ws_size < WS_END) { fprintf(stderr, "kernel_launch: unexpected shapes / workspace (n_in %d, ws %zu)\n", n_in, ws_size); grid = -1; return; }
        int dev = 0, cus = 0, per_cu = 0;
        if (hipGetDevice(&dev) != hipSuccess || hipDeviceGetAttribute(&cus, hipDeviceAttributeMultiprocessorCount, dev) != hipSuccess) { grid = -1; return; }
        if (hipFuncSetAttribute((const void*)fwd_kernel, hipFuncAttributeMaxDynamicSharedMemorySize, LDS_BYTES) != hipSuccess) { fprintf(stderr, "kernel_launch: hipFuncSetAttribute failed\n"); grid = -1; return; }
        if (hipOccupancyMaxActiveBlocksPerMultiprocessor(&per_cu, (const void*)fwd_kernel, NTHREADS, LDS_BYTES) != hipSuccess || per_cu < 1) { fprintf(stderr, "kernel_launch: occupancy query failed (%d)\n", per_cu); (void)hipGetLastError(); per_cu = 1; }
        grid = cus * per_cu;
    }
    if (grid < 0) return;
    (void)hipMemsetAsync((char*)d_ws + WS_CTL, 0, CTL_ZERO_BYTES, stream);
    Params a{};
    for (int i = 0; i < 26; ++i) a.in[i] = (const float*)d_in[i];
    a.out = (float*)d_out; a.ws = (unsigned char*)d_ws;
    if (N_LAUNCHES == 1) {
        a.ph_lo = 0; a.ph_hi = NPHASE; a.li = 0;
        void* args[] = {&a};
        hipError_t e = hipLaunchCooperativeKernel((const void*)fwd_kernel, dim3(grid), dim3(NTHREADS), args, LDS_BYTES, stream);
        if (e != hipSuccess) fprintf(stderr, "kernel_launch: cooperative launch failed: %s (grid %d)\n", hipGetErrorString(e), grid);
    } else {
        for (int li = 0; li < NPHASE; ++li) {
            a.ph_lo = li; a.ph_hi = li + 1; a.li = li;
            hipLaunchKernelGGL(fwd_kernel, dim3(grid), dim3(NTHREADS), LDS_BYTES, stream, a);
        }
    }
}
```

```cpp
#include <hip/hip_runtime.h>
#include <cstdio>
#include <cstdint>

#ifndef MK_N_LAUNCHES
#define MK_N_LAUNCHES 1
#endif

#define GAS __attribute__((address_space(1)))
#define LAS __attribute__((address_space(3)))
typedef unsigned short bf16;
typedef float f32x4 __attribute__((ext_vector_type(4)));
typedef unsigned u32x4 __attribute__((ext_vector_type(4)));
typedef unsigned u32x2 __attribute__((ext_vector_type(2)));

constexpr int BATCH = 4, SEQ = 8192, DM = 1024, M = BATCH * SEQ;
constexpr int RW_COLS = 1792, FOX_COLS = 1544, IN_COLS = 3336;
constexpr int C_R = 0, C_PW = 512, C_K = 576, C_V = 1088, C_PA = 1600, C_PG = 1664;
constexpr int NEXP = 64, DEXP = 512, NSEG = 128;
constexpr float LOG2E = 1.4426950408889634f;
constexpr float QSCALE = 0.125f * LOG2E;
constexpr int NWAVES = 8, NTHREADS = 512;
constexpr int NPHASE = 13;
constexpr int N_LAUNCHES = MK_N_LAUNCHES;
constexpr int LDS_BYTES = 147456;

constexpr size_t MiB = 1u << 20;
constexpr size_t WS_CTL = 0, CTL_ZERO_BYTES = 1 * MiB;
constexpr size_t WS_WINT = 2 * MiB;
constexpr size_t WS_WOUTT = 10 * MiB;
constexpr size_t WS_LORA = 12 * MiB;
constexpr size_t WS_LOGF = 13 * MiB, WS_CUMF = 14 * MiB;
constexpr size_t WS_XN = 16 * MiB;
constexpr size_t WS_YMIX = 16 * MiB;
constexpr size_t WS_H2 = 16 * MiB;
constexpr size_t WS_PRW = 80 * MiB;
constexpr size_t WS_QF = 192 * MiB, WS_KF = 224 * MiB, WS_VF = 256 * MiB;
constexpr size_t WS_SCR = 192 * MiB;
constexpr size_t WS_PQ = 288 * MiB;
constexpr size_t WS_GY = 352 * MiB;
constexpr size_t WS_GT = 416 * MiB;
constexpr size_t WS_S0 = 448 * MiB;
constexpr size_t WS_BON = 480 * MiB;
constexpr size_t WS_HID = 288 * MiB;
constexpr size_t WS_EWGU = 80 * MiB;
constexpr size_t WS_EWD = 208 * MiB;
constexpr size_t WS_EID = 482 * MiB;
constexpr size_t WS_GATE = WS_EID + 256 * 1024, WS_RANK = WS_GATE + 256 * 1024, WS_LIST = WS_RANK + 256 * 1024, WS_LG = WS_LIST + 512 * 1024;
constexpr size_t WS_END = 485 * MiB;
constexpr int CW_CNT = 64;
constexpr int CW_BAR = 4096;
constexpr int CW_AQ = 256;
constexpr int NWIN = 3328;

struct Params {
    const float* in[26];
    float* out;
    unsigned char* ws;
    int ph_lo, ph_hi, li, pad;
};
#define CAS __attribute__((address_space(4)))
typedef CAS Params CParams;
__device__ __forceinline__ const CParams* kp_launder(const CParams* q) { asm volatile("" : "+s"(q)); return q; }

__device__ __forceinline__ float bf2f(unsigned u) { return __uint_as_float(u << 16); }
__device__ __forceinline__ unsigned f2bf(float f) { unsigned u = __float_as_uint(f); return (u + 0x7fffu + ((u >> 16) & 1u)) >> 16; }
__device__ __forceinline__ unsigned pk2(float lo, float hi) { return f2bf(lo) | (f2bf(hi) << 16); }
typedef float f32x2_t __attribute__((ext_vector_type(2))); typedef __bf16 bf16x2_t __attribute__((ext_vector_type(2)));
__device__ __forceinline__ unsigned cvtpk_c(float lo, float hi) { f32x2_t v = {lo, hi}; bf16x2_t b = __builtin_convertvector(v, bf16x2_t); return __builtin_bit_cast(unsigned, b); }
__device__ __forceinline__ float wave_sum(float v) {
#pragma unroll
    for (int o = 1; o < 64; o <<= 1) v += __shfl_xor(v, o);
    return v;
}
__device__ __forceinline__ float sigmoidf_(float x) { return 1.0f / (1.0f + __expf(-x)); }
__device__ __forceinline__ float softplusf_(float z) { return fmaxf(z, 0.f) + log1pf(__expf(-fabsf(z))); }

#define XB_TMO      128
#define XB_XCNT(j)  (256  + 64 * (j))
#define XB_XSUB(j)  (1280 + 64 * (j))
#define XB_XGEN(j)  (2304 + 64 * (j))
#define XB_TOP      3328
#define XB_TOPGEN   3392
#define XCD_BAR_WORDS 3456
#define XB_SPIN_CAP (1u << 22)
__device__ __forceinline__ unsigned xb_ld(unsigned* p)              { return __hip_atomic_load(p, __ATOMIC_RELAXED, __HIP_MEMORY_SCOPE_AGENT); }
__device__ __forceinline__ unsigned xb_add(unsigned* p, unsigned v) { return __hip_atomic_fetch_add(p, v, __ATOMIC_RELAXED, __HIP_MEMORY_SCOPE_AGENT); }
__device__ __forceinline__ unsigned xb_xcc_id() { return (unsigned)__builtin_amdgcn_s_getreg((3 << 11) | 20) & 0xFu; }
#define XB_SPIN(cond, bar) do { unsigned _sp = 0; while (cond) { __builtin_amdgcn_s_sleep(1); \
    if ((++_sp & 255u) == 0u) { if (xb_ld(&(bar)[XB_TMO])) break; if (_sp > XB_SPIN_CAP) { atomicAdd(&(bar)[XB_TMO], 1u); break; } } } } while (0)
struct XcdBarrier { unsigned* bar; unsigned x; volatile LAS unsigned* st; };
__device__ __forceinline__ XcdBarrier xcd_barrier_post(unsigned* bar, volatile LAS unsigned* st) {
    XcdBarrier b; b.bar = bar; b.x = xb_xcc_id(); b.st = st;
    if (threadIdx.x == 0) (void)xb_add(&bar[XB_XCNT(b.x)], 1u);
    return b;
}
__device__ __forceinline__ void xcd_barrier_complete(unsigned* bar, unsigned x, unsigned& nloc, unsigned& nx) {
    const unsigned G = gridDim.x * gridDim.y * gridDim.z;
    unsigned sum, cnt, mine, sp = 0u;
    for (;;) {
        sum = 0u; cnt = 0u; mine = 0u;
#pragma unroll
        for (unsigned j = 0; j < 16; ++j) { const unsigned c = xb_ld(&bar[XB_XCNT(j)]); sum += c; cnt += (c > 0u) ? 1u : 0u; mine = (j == x) ? c : mine; }
        if (sum == G) break;
        __builtin_amdgcn_s_sleep(1);
        if ((++sp & 255u) == 0u) { if (xb_ld(&bar[XB_TMO])) break; if (sp > XB_SPIN_CAP) { atomicAdd(&bar[XB_TMO], 1u); break; } }
    }
    nloc = mine > 0u ? mine : 1u; nx = cnt > 0u ? cnt : 1u;
}
__device__ __forceinline__ void xcd_barrier(const XcdBarrier& b) {
    asm volatile("s_waitcnt vmcnt(0)" ::: "memory");
    __syncthreads();
    if (threadIdx.x == 0) {
        unsigned* bar = b.bar;
        __builtin_amdgcn_s_waitcnt(0);
        unsigned nloc = b.st[0], nx = b.st[1];
        if (nloc == 0u) { xcd_barrier_complete(bar, b.x, nloc, nx); b.st[0] = nloc; b.st[1] = nx; }
        const unsigned old = xb_add(&bar[XB_XSUB(b.x)], 1u);
        const unsigned gen = old / nloc;
        if (old + 1u == (gen + 1u) * nloc) {
            __builtin_amdgcn_fence(__ATOMIC_RELEASE, "agent");
            asm volatile("s_waitcnt vmcnt(0)" ::: "memory");
            const unsigned og = xb_add(&bar[XB_TOP], 1u);
            const unsigned tg = og / nx;
            if (og + 1u == (tg + 1u) * nx) xb_add(&bar[XB_TOPGEN], 1u);
            else XB_SPIN(xb_ld(&bar[XB_TOPGEN]) == tg, bar);
            __builtin_amdgcn_fence(__ATOMIC_ACQUIRE, "agent");
            xb_add(&bar[XB_XGEN(b.x)], 1u);
            asm volatile("s_waitcnt vmcnt(0)" ::: "memory");
        } else {
            XB_SPIN(xb_ld(&bar[XB_XGEN(b.x)]) == gen, bar);
            __builtin_amdgcn_fence(__ATOMIC_ACQUIRE, "agent");
            asm volatile("s_waitcnt vmcnt(0)" ::: "memory");
        }
    }
    __syncthreads();
}

namespace pg8 {
typedef short bf16x8 __attribute__((ext_vector_type(8)));
constexpr int BM = 256, BK = 64, HALF = 128, HTB = HALF * BK * 2, STAGE_BYTES = 8 * HTB, NXCD = 8;
__host__ __device__ __forceinline__ int lds_byte(int r, int c) { const int st = (r >> 4) * 2 + (c >> 5), rr = r & 15, cc = c & 31, ob = rr * 64 + cc * 2; return st * 1024 + (ob ^ (((ob >> 9) & 1) << 5)); }
__host__ __device__ __forceinline__ void stage_rc(int b, int& R, int& C) { const int st = b / 1024, sb = b % 1024, swz = sb ^ (((sb >> 9) & 1) << 5); R = (st >> 1) * 16 + swz / 64; C = (st & 1) * 32 + (swz % 64) / 2; }
__host__ __device__ __forceinline__ int perm32(int rho) { const int n = rho >> 4, i = rho & 15; return 8 * (i >> 2) + 4 * n + (i & 3); }
struct Unit { int arow; int pm, pn; int nvalid; int seg; unsigned boff_lo, boff_hi; };
__device__ __forceinline__ size_t unit_boff(const Unit& u) { return ((size_t)u.boff_hi << 32) | u.boff_lo; }
__device__ __forceinline__ void set_boff(Unit& u, size_t b) { u.boff_lo = (unsigned)b; u.boff_hi = (unsigned)(b >> 32); }
__device__ __forceinline__ unsigned cvt_pk_bf16(float lo, float hi) { return cvtpk_c(lo, hi); }

struct DenseOrder {
    int nM, nN, nwg, G, c, K;
    __device__ void init(int M_, int N_, int K_, int G_, int c_) { nM = M_ / BM; nN = N_ / BM; nwg = nM * nN; G = G_; c = c_; K = K_; }
    __device__ bool next(int i, Unit& u) const {
        const long L = (long)i * G + c; if (L >= nwg) return false;
        int wgid = (int)L; { const int q = nwg / NXCD, r = nwg % NXCD, xcd = wgid % NXCD, off = wgid / NXCD; wgid = (xcd < r ? xcd * (q + 1) : r * (q + 1) + (xcd - r) * q) + off; }
        const int WGM = 8, nig = WGM * nN, gid = wgid / nig, fm = gid * WGM, gsz = (nM - fm) < WGM ? (nM - fm) : WGM;
        u.pm = fm + ((wgid % nig) % gsz); u.pn = (wgid % nig) / gsz; u.arow = u.pm * BM; u.nvalid = BM; u.seg = 0; set_boff(u, (size_t)u.pn * BM * K * 2);
        return true;
    }
};

template <class Epi, class Sched, bool ALIGN_EPI, bool GATHER>
__device__ __forceinline__ void gemm_phase(LAS unsigned char* lds, const bf16* A, const bf16* Bt, const int K, const int* list, const Sched& S, const Epi& E) {
    const int tid = threadIdx.x, wid = __builtin_amdgcn_readfirstlane(tid >> 6), lane = tid & 63, wr = wid >> 2, wc = wid & 3, fr = lane & 15, fq = lane >> 4;
    const int nt = K / BK;
    int Rr[2], Cc[2]; unsigned voffB[2];
#pragma unroll
    for (int i = 0; i < 2; ++i) { int R, C; stage_rc(tid * 16 + i * 8192, R, C); Rr[i] = R; Cc[i] = C; const int Rb = Epi::PERM ? ((R & ~31) + perm32(R & 31)) : R; voffB[i] = (unsigned)(Rb * K + C) * 2u; }
    const size_t kstep = (size_t)(BK * 2);
    const size_t hstepB = (size_t)HALF * K * 2;
    const unsigned ldsw = (unsigned)wid * 1024u;
    const int aoff = lds_byte(wr * 64 + fr, fq * 8), boff = lds_byte(wc * 32 + fr, fq * 8);
#define PG8_SA(b, h) (((b) * 2 + (h)) * HTB)
#define PG8_SB(b, h) ((4 + (b) * 2 + (h)) * HTB)
#define PG8_STAGE_A(bufoff, gbase, VO) do { _Pragma("unroll") for (int _i = 0; _i < 2; ++_i) \
        __builtin_amdgcn_global_load_lds((const unsigned*)((const char*)(gbase) + (VO)[_i]), (LAS unsigned*)(lds + (bufoff) + ldsw + _i * 8192), 16, 0, 0); } while (0)
#define PG8_STAGE_B(bufoff, gbase) do { _Pragma("unroll") for (int _i = 0; _i < 2; ++_i) \
        __builtin_amdgcn_global_load_lds((const unsigned*)((const char*)(gbase) + voffB[_i]), (LAS unsigned*)(lds + (bufoff) + ldsw + _i * 8192), 16, 0, 0); } while (0)
#define PG8_LDA(dst, b, h) do { _Pragma("unroll") for (int m = 0; m < 4; ++m) _Pragma("unroll") for (int k = 0; k < 2; ++k) dst[m][k] = *(const LAS bf16x8*)(lds + PG8_SA(b, h) + aoff + m * 2048 + k * 1024); } while (0)
#define PG8_LDB(dst, b, h) do { _Pragma("unroll") for (int n = 0; n < 2; ++n) _Pragma("unroll") for (int k = 0; k < 2; ++k) dst[n][k] = *(const LAS bf16x8*)(lds + PG8_SB(b, h) + boff + n * 2048 + k * 1024); } while (0)
#define PG8_MMA(ai, bj, At, Bt_) do { __builtin_amdgcn_s_setprio(1); _Pragma("unroll") for (int m = 0; m < 4; ++m) _Pragma("unroll") for (int n = 0; n < 2; ++n) _Pragma("unroll") for (int k = 0; k < 2; ++k) \
        acc[ai][bj][m][n] = __builtin_amdgcn_mfma_f32_16x16x32_bf16(Bt_[n][k], At[m][k], acc[ai][bj][m][n], 0, 0, 0); __builtin_amdgcn_s_setprio(0); } while (0)
#define PG8_WAIT_V(n) asm volatile("s_waitcnt vmcnt(" #n ")" ::: "memory")
#define PG8_WAIT_L(n) asm volatile("s_waitcnt lgkmcnt(" #n ")" ::: "memory")
#define PG8_BAR __builtin_amdgcn_s_barrier()
#define PG8_SCHED __builtin_amdgcn_sched_barrier(0)
#define PG8_MKVO(u, vo) do { _Pragma("unroll") for (int _h = 0; _h < 2; ++_h) _Pragma("unroll") for (int _i = 0; _i < 2; ++_i) { const int _row = _h * HALF + Rr[_i]; \
        const int _src = GATHER ? list[(u).arow + (_row < (u).nvalid ? _row : 0)] : (u).arow + _row; vo[_h][_i] = (unsigned)(_src * K + Cc[_i]) * 2u; } } while (0)
    Unit cur, nxt; int ui = 0;
    if (!S.next(0, cur)) return;
    unsigned cvo[2][2], nvo[2][2];
    PG8_MKVO(cur, cvo);
#pragma unroll
    for (int _h = 0; _h < 2; ++_h) { nvo[_h][0] = cvo[_h][0]; nvo[_h][1] = cvo[_h][1]; }
    f32x4 acc[2][2][4][2];
#pragma unroll
    for (int a = 0; a < 2; ++a)
#pragma unroll
        for (int b = 0; b < 2; ++b)
#pragma unroll
            for (int m = 0; m < 4; ++m)
#pragma unroll
                for (int n = 0; n < 2; ++n) acc[a][b][m][n] = (f32x4){0.f, 0.f, 0.f, 0.f};
    bf16x8 At[4][2], B0[2][2], B1[2][2];
    const char* const Ab = (const char*)A;
    const char* cB = (const char*)Bt + unit_boff(cur);
    PG8_STAGE_B(PG8_SB(0, 0), cB); PG8_STAGE_B(PG8_SB(0, 1), cB + hstepB); PG8_STAGE_A(PG8_SA(0, 0), Ab, cvo[0]); PG8_STAGE_A(PG8_SA(0, 1), Ab, cvo[1]);
    if (wr == 1) PG8_BAR;
    PG8_WAIT_V(2); PG8_BAR;
    PG8_STAGE_B(PG8_SB(1, 0), cB + kstep); PG8_STAGE_A(PG8_SA(1, 0), Ab + kstep, cvo[0]); PG8_STAGE_B(PG8_SB(1, 1), cB + hstepB + kstep);
    PG8_WAIT_V(6); PG8_BAR;
    for (;;) {
        const bool has_next = S.next(ui + 1, nxt);
        if (has_next) PG8_MKVO(nxt, nvo);
        const char* nB = has_next ? (const char*)Bt + unit_boff(nxt) : cB;
        for (int t = 0; t < nt; t += 2) {
            const bool last = (t == nt - 2), usen = last && has_next;
            const char* a1 = Ab + (size_t)(t + 1) * kstep;
            const char* a2 = last ? Ab : Ab + (size_t)(t + 2) * kstep; const char* b2 = last ? nB : cB + (size_t)(t + 2) * kstep;
            const char* a3 = a2 + kstep; const char* b3 = b2 + kstep;
            unsigned s0[2], s1[2];
            s0[0] = usen ? nvo[0][0] : cvo[0][0]; s0[1] = usen ? nvo[0][1] : cvo[0][1]; s1[0] = usen ? nvo[1][0] : cvo[1][0]; s1[1] = usen ? nvo[1][1] : cvo[1][1];
            PG8_LDB(B0, 0, 0); PG8_LDB(B1, 0, 1); PG8_SCHED; PG8_LDA(At, 0, 0); PG8_STAGE_A(PG8_SA(1, 1), a1, cvo[1]);
            PG8_WAIT_V(8); PG8_WAIT_L(0); PG8_BAR; PG8_MMA(0, 0, At, B0); PG8_MMA(0, 1, At, B1); PG8_BAR; PG8_SCHED;
            PG8_LDA(At, 0, 1); PG8_STAGE_B(PG8_SB(0, 0), b2); PG8_STAGE_B(PG8_SB(0, 1), b2 + hstepB); PG8_STAGE_A(PG8_SA(0, 0), a2, s0);
            PG8_WAIT_V(8); PG8_WAIT_L(0); PG8_BAR; PG8_MMA(1, 0, At, B0); PG8_MMA(1, 1, At, B1); PG8_BAR; PG8_SCHED;
            PG8_LDB(B0, 1, 0); PG8_LDB(B1, 1, 1); PG8_SCHED; PG8_LDA(At, 1, 0); PG8_STAGE_A(PG8_SA(0, 1), a2, s1);
            PG8_WAIT_V(8); PG8_WAIT_L(0); PG8_BAR; PG8_MMA(0, 0, At, B0); PG8_MMA(0, 1, At, B1); PG8_BAR; PG8_SCHED;
            PG8_LDA(At, 1, 1); PG8_STAGE_B(PG8_SB(1, 0), b3); PG8_STAGE_B(PG8_SB(1, 1), b3 + hstepB); PG8_STAGE_A(PG8_SA(1, 0), a3, s0);
            PG8_WAIT_V(8); PG8_WAIT_L(0); PG8_BAR; PG8_MMA(1, 0, At, B0); PG8_MMA(1, 1, At, B1); PG8_BAR; PG8_SCHED;
        }
        if constexpr (ALIGN_EPI) { if (wr == 0) PG8_BAR; }
        E(acc, cur, wr, wc, fr, fq, lds);
        if (!has_next) break;
#pragma unroll
        for (int a = 0; a < 2; ++a)
#pragma unroll
            for (int b = 0; b < 2; ++b)
#pragma unroll
                for (int m = 0; m < 4; ++m)
#pragma unroll
                    for (int n = 0; n < 2; ++n) acc[a][b][m][n] = (f32x4){0.f, 0.f, 0.f, 0.f};
        cur = nxt; cB = nB; ++ui;
#pragma unroll
        for (int _h = 0; _h < 2; ++_h) { cvo[_h][0] = nvo[_h][0]; cvo[_h][1] = nvo[_h][1]; }
        if constexpr (ALIGN_EPI) { if (wr == 1) PG8_BAR; }
    }
    PG8_WAIT_V(0);
    if constexpr (!ALIGN_EPI) { if (wr == 0) PG8_BAR; }
    PG8_BAR;
#undef PG8_SA
#undef PG8_SB
#undef PG8_STAGE_A
#undef PG8_STAGE_B
#undef PG8_LDA
#undef PG8_LDB
#undef PG8_MMA
#undef PG8_WAIT_V
#undef PG8_WAIT_L
#undef PG8_BAR
#undef PG8_SCHED
#undef PG8_MKVO
}
}

__device__ __forceinline__ void transpose_item(const float* W, int pitch, int K, bf16* WT, int wt_row, int k0, int n0, LAS float* scr, int lane) {
#pragma unroll 8
    for (int i = 0; i < 32; ++i) { const int kk = 2 * i + (lane >> 5); scr[kk * 33 + (lane & 31)] = W[(size_t)(k0 + kk) * pitch + n0 + (lane & 31)]; }
    asm volatile("s_waitcnt lgkmcnt(0)" ::: "memory");
    const int c = lane & 7;
#pragma unroll
    for (int j = 0; j < 4; ++j) { const int n = (lane >> 3) + 8 * j; const LAS float* t = scr + (8 * c) * 33 + n;
        u32x4 o; o.x = pk2(t[0 * 33], t[1 * 33]); o.y = pk2(t[2 * 33], t[3 * 33]); o.z = pk2(t[4 * 33], t[5 * 33]); o.w = pk2(t[6 * 33], t[7 * 33]);
        *(u32x4*)(WT + (size_t)(wt_row + n) * K + k0 + 8 * c) = o; }
    asm volatile("s_waitcnt lgkmcnt(0)" ::: "memory");
}

__device__ __forceinline__ void ph0_prologue(const CParams& p, LAS unsigned char* ldsb) {
    const int lane = threadIdx.x & 63, wave = __builtin_amdgcn_readfirstlane(threadIdx.x >> 6);
    const float* x = p.in[0]; const float* nw = p.in[1]; const float* win = p.in[2]; bf16* XN = (bf16*)(p.ws + WS_XN); float* LOGF = (float*)(p.ws + WS_LOGF);
    LAS float* scr = (LAS float*)(ldsb + wave * 8704);
    LAS float* Wf = (LAS float*)(ldsb + 73728);
    for (int i = threadIdx.x; i < 8192; i += NTHREADS) Wf[i] = win[(size_t)(i >> 3) * IN_COLS + NWIN + (i & 7)];
    const int gw = blockIdx.x * NWAVES + wave, NGW = gridDim.x * NWAVES;
    constexpr int I_IN = 16 * (NWIN / 32), I_OUT = 16 * 32, I_LORA = 16 + 16 + 32;
    for (int it = gw; it < I_IN + I_OUT + I_LORA; it += NGW) {
        if (it >= I_IN + I_OUT) { const int r = it - I_IN - I_OUT; bf16* L = (bf16*)(p.ws + WS_LORA);
            if (r < 16) transpose_item(p.in[5], 512, 64, L, r * 32, 0, r * 32, scr, lane);
            else if (r < 32) transpose_item(p.in[7], 512, 64, L + 512 * 64, (r - 16) * 32, 0, (r - 16) * 32, scr, lane);
            else { const int q = r - 32; transpose_item(p.in[8], 512, 128, L + 2 * 512 * 64, (q & 15) * 32, (q >> 4) * 64, (q & 15) * 32, scr, lane); }
            continue; }
        if (it < I_IN) { const int kb = it / (NWIN / 32), nb = it % (NWIN / 32); transpose_item(win, IN_COLS, DM, (bf16*)(p.ws + WS_WINT), nb * 32, kb * 64, nb * 32, scr, lane); }
        else { const int r = it - I_IN, kb = r >> 5, nb = r & 31; transpose_item(p.in[17], DM, DM, (bf16*)(p.ws + WS_WOUTT), nb * 32, kb * 64, nb * 32, scr, lane); }
    }
    __syncthreads();
    f32x4 w[4];
#pragma unroll
    for (int j = 0; j < 4; ++j) w[j] = ((const f32x4*)nw)[lane + 64 * j];
    const float bfl = p.in[14][lane & 7];
    for (int m = gw; m < M; m += NGW) {
        const f32x4* xr = (const f32x4*)(x + (size_t)m * DM) + lane;
        f32x4 v[4]; float s = 0.f;
#pragma unroll
        for (int j = 0; j < 4; ++j) { v[j] = xr[64 * j]; s += (v[j].x * v[j].x + v[j].y * v[j].y) + (v[j].z * v[j].z + v[j].w * v[j].w); }
        const float rstd = rsqrtf(wave_sum(s) * (1.f / DM) + 1e-6f);
        u32x2* o = (u32x2*)(XN + (size_t)m * DM) + lane;
        float fl[8];
#pragma unroll
        for (int e = 0; e < 8; ++e) fl[e] = 0.f;
#pragma unroll
        for (int j = 0; j < 4; ++j) {
            const float h0 = v[j].x * rstd * w[j].x, h1 = v[j].y * rstd * w[j].y, h2 = v[j].z * rstd * w[j].z, h3 = v[j].w * rstd * w[j].w;
            o[64 * j] = (u32x2){pk2(h0, h1), pk2(h2, h3)};
            const float hh[4] = {h0, h1, h2, h3};
#pragma unroll
            for (int c = 0; c < 4; ++c) { const LAS f32x4* wr_ = (const LAS f32x4*)(Wf + ((lane + 64 * j) * 4 + c) * 8); const f32x4 a = wr_[0], b = wr_[1];
                fl[0] += hh[c] * a.x; fl[1] += hh[c] * a.y; fl[2] += hh[c] * a.z; fl[3] += hh[c] * a.w; fl[4] += hh[c] * b.x; fl[5] += hh[c] * b.y; fl[6] += hh[c] * b.z; fl[7] += hh[c] * b.w; }
        }
        float mine = 0.f;
#pragma unroll
        for (int e = 0; e < 8; ++e) { const float t = wave_sum(fl[e]); if ((lane & 7) == e) mine = t; }
        if (lane < 8) LOGF[(size_t)m * 8 + lane] = -softplusf_(-(mine + bfl));
    }
}

struct EpiWin {
    static constexpr bool PERM = true;
    bf16* PRW; bf16* QF; bf16* KF; bf16* VF; const float* qw; const float* kw;
    __device__ __forceinline__ void operator()(const f32x4 (&acc)[2][2][4][2], const pg8::Unit& u, int wr, int wc, int fr, int fq, LAS unsigned char* lds) const {
        const int row0 = u.pm * 256 + wr * 64 + fr, cw = wc * 32 + 8 * fq;
        if (u.pn < 7 || u.pn >= 11) {
            bf16* base = u.pn < 7 ? PRW + u.pn * 256 : VF + (u.pn - 11) * 256; const int ldc = u.pn < 7 ? RW_COLS : 512;
#pragma unroll
            for (int ai = 0; ai < 2; ++ai)
#pragma unroll
                for (int m = 0; m < 4; ++m) { bf16* rowp = base + (size_t)(row0 + ai * 128 + m * 16) * ldc + cw;
#pragma unroll
                    for (int bj = 0; bj < 2; ++bj) { const f32x4 v0 = acc[ai][bj][m][0], v1 = acc[ai][bj][m][1];
                        *(u32x4*)(rowp + bj * 128) = (u32x4){pg8::cvt_pk_bf16(v0[0], v0[1]), pg8::cvt_pk_bf16(v0[2], v0[3]), pg8::cvt_pk_bf16(v1[0], v1[1]), pg8::cvt_pk_bf16(v1[2], v1[3])}; } }
        } else {
            const bool isq = u.pn < 9; bf16* O = (isq ? QF : KF) + ((u.pn - 7) & 1) * 256; const float* wsrc = (isq ? qw : kw) + 32 * (wc & 1) + 8 * fq; const float sc = isq ? QSCALE : 1.f;
            LAS float* ex = (LAS float*)(lds + 131072);
#pragma unroll
            for (int ai = 0; ai < 2; ++ai)
#pragma unroll
                for (int bj = 0; bj < 2; ++bj)
#pragma unroll
                    for (int m = 0; m < 4; ++m) { const f32x4 v0 = acc[ai][bj][m][0], v1 = acc[ai][bj][m][1];
                        float ss = (v0[0] * v0[0] + v0[1] * v0[1]) + (v0[2] * v0[2] + v0[3] * v0[3]) + (v1[0] * v1[0] + v1[1] * v1[1]) + (v1[2] * v1[2] + v1[3] * v1[3]);
                        ss += __shfl_xor(ss, 16); ss += __shfl_xor(ss, 32);
                        if (fq == 0) ex[((ai * 128 + wr * 64 + m * 16 + fr) * 4 + 2 * bj + (wc >> 1)) * 2 + (wc & 1)] = ss; }
            asm volatile("s_waitcnt lgkmcnt(0)\n\ts_barrier" ::: "memory");
            float wv[8];
#pragma unroll
            for (int j = 0; j < 8; ++j) wv[j] = wsrc[j] * sc;
#pragma unroll
            for (int ai = 0; ai < 2; ++ai)
#pragma unroll
                for (int m = 0; m < 4; ++m) { bf16* rowp = O + (size_t)(row0 + ai * 128 + m * 16) * 512 + cw;
#pragma unroll
                    for (int bj = 0; bj < 2; ++bj) { const LAS float* e2 = ex + ((ai * 128 + wr * 64 + m * 16 + fr) * 4 + 2 * bj + (wc >> 1)) * 2;
                        const float rs = rsqrtf((e2[0] + e2[1]) * (1.f / 64.f) + 1e-6f); const f32x4 v0 = acc[ai][bj][m][0], v1 = acc[ai][bj][m][1];
                        *(u32x4*)(rowp + bj * 128) = (u32x4){pg8::cvt_pk_bf16(v0[0] * rs * wv[0], v0[1] * rs * wv[1]), pg8::cvt_pk_bf16(v0[2] * rs * wv[2], v0[3] * rs * wv[3]),
                                                             pg8::cvt_pk_bf16(v1[0] * rs * wv[4], v1[1] * rs * wv[5]), pg8::cvt_pk_bf16(v1[2] * rs * wv[6], v1[3] * rs * wv[7])}; } }
        }
    }
};
__device__ __forceinline__ void ph1_win(const CParams& p, LAS unsigned char* ldsb) {
    pg8::DenseOrder S; S.init(M, NWIN, DM, gridDim.x, blockIdx.x);
    EpiWin E{(bf16*)(p.ws + WS_PRW), (bf16*)(p.ws + WS_QF), (bf16*)(p.ws + WS_KF), (bf16*)(p.ws + WS_VF), p.in[15], p.in[16]};
    pg8::gemm_phase<EpiWin, pg8::DenseOrder, true, false>(ldsb, (const bf16*)(p.ws + WS_XN), (const bf16*)(p.ws + WS_WINT), DM, nullptr, S, E);
}

__device__ __forceinline__ void ph3_cumsum(const CParams& p, float* lds) {
    if (blockIdx.x >= 32) return;
    const int tid = threadIdx.x, b = blockIdx.x >> 3, h = blockIdx.x & 7;
    const float* LOGF = (const float*)(p.ws + WS_LOGF); float* CUMF = (float*)(p.ws + WS_CUMF);
    float v[16]; float run = 0.f;
#pragma unroll
    for (int i = 0; i < 16; ++i) { run += LOGF[((size_t)b * SEQ + tid * 16 + i) * 8 + h]; v[i] = run; }
    lds[tid] = run; __syncthreads();
    for (int off = 1; off < 512; off <<= 1) { float a = (tid >= off) ? lds[tid - off] : 0.f; __syncthreads(); lds[tid] += a; __syncthreads(); }
    const float base = lds[tid] - run;
#pragma unroll
    for (int i = 0; i < 16; ++i) CUMF[((size_t)b * SEQ + tid * 16 + i) * 8 + h] = base + v[i];
}

namespace fox {
typedef short bf16x8 __attribute__((ext_vector_type(8)));
typedef short s16x4 __attribute__((ext_vector_type(4)));
typedef float f32x16 __attribute__((ext_vector_type(16)));
constexpr int L_K = 0, L_V = 16384, L_C = 32768, L_WS = 33280, L_OST = 36864;
constexpr float THRESH = 25.0f;
__device__ __forceinline__ int crow(int r, int hi) { return (r & 3) + 8 * (r >> 2) + 4 * hi; }
__device__ __forceinline__ unsigned cvtpk(float lo, float hi) { return cvtpk_c(lo, hi); }
__device__ __forceinline__ s16x4 vtr(const LAS unsigned char* p) { typedef short v4i16_t __attribute__((ext_vector_type(4))); return __builtin_bit_cast(s16x4, __builtin_amdgcn_ds_read_tr16_b64_v4i16((LAS v4i16_t*)p)); }

template <bool MASKED>
__device__ __forceinline__ void tile_step(const LAS unsigned char* lds, int buf, const bf16x8 (&qr)[4], f32x16 (&o)[2], float& m_run, float& l_run, LAS float* wsf, int r32, int hi, int kv0, int qg) {
    f32x16 p0, p1;
    { const LAS f32x4* cb = (const LAS f32x4*)(lds + L_C + buf * 256);
#pragma unroll
      for (int g = 0; g < 4; ++g) { const f32x4 a = cb[2 * g + hi], b = cb[8 + 2 * g + hi];
          p0[4 * g] = a.x; p0[4 * g + 1] = a.y; p0[4 * g + 2] = a.z; p0[4 * g + 3] = a.w; p1[4 * g] = b.x; p1[4 * g + 1] = b.y; p1[4 * g + 2] = b.z; p1[4 * g + 3] = b.w; } }
    const LAS unsigned char* kb = lds + L_K + buf * 8192 + hi * 1024 + r32 * 16;
#pragma unroll
    for (int d0 = 0; d0 < 4; ++d0) {
        const bf16x8 k0 = *(const LAS bf16x8*)(kb + d0 * 2048), k1 = *(const LAS bf16x8*)(kb + d0 * 2048 + 512);
        p0 = __builtin_amdgcn_mfma_f32_32x32x16_bf16(k0, qr[d0], p0, 0, 0, 0);
        p1 = __builtin_amdgcn_mfma_f32_32x32x16_bf16(k1, qr[d0], p1, 0, 0, 0);
    }
    if (MASKED) {
#pragma unroll
        for (int r = 0; r < 16; ++r) { const int kv = kv0 + crow(r, hi); if (kv > qg) p0[r] = -INFINITY; if (kv + 32 > qg) p1[r] = -INFINITY; }
    }
    float mx = fmaxf(p0[0], p1[0]);
#pragma unroll
    for (int r = 1; r < 16; ++r) mx = fmaxf(mx, fmaxf(p0[r], p1[r]));
    { auto rr = __builtin_amdgcn_permlane32_swap(__float_as_uint(mx), __float_as_uint(mx), false, false); mx = fmaxf(__uint_as_float(rr[0]), __uint_as_float(rr[1])); }
    if (__any(mx > m_run)) {
        const float m_new = fmaxf(m_run, mx), alpha = __builtin_amdgcn_exp2f(m_run - m_new);
        m_run = m_new; l_run *= alpha;
        if (hi == 0) wsf[r32] = alpha;
        asm volatile("s_waitcnt lgkmcnt(0)" ::: "memory");
#pragma unroll
        for (int g = 0; g < 4; ++g) { const f32x4 a = *(const LAS f32x4*)(wsf + 8 * g + 4 * hi);
            o[0][4 * g] *= a.x; o[0][4 * g + 1] *= a.y; o[0][4 * g + 2] *= a.z; o[0][4 * g + 3] *= a.w; o[1][4 * g] *= a.x; o[1][4 * g + 1] *= a.y; o[1][4 * g + 2] *= a.z; o[1][4 * g + 3] *= a.w; }
    }
    float sum = 0.f;
#pragma unroll
    for (int r = 0; r < 16; ++r) { p0[r] = __builtin_amdgcn_exp2f(p0[r] - m_run); p1[r] = __builtin_amdgcn_exp2f(p1[r] - m_run); sum += p0[r] + p1[r]; }
    l_run += sum;
    u32x4 pw[4];
#pragma unroll
    for (int j = 0; j < 4; ++j) { pw[0][j] = cvtpk(p0[2 * j], p0[2 * j + 1]); pw[1][j] = cvtpk(p0[8 + 2 * j], p0[9 + 2 * j]); pw[2][j] = cvtpk(p1[2 * j], p1[2 * j + 1]); pw[3][j] = cvtpk(p1[8 + 2 * j], p1[9 + 2 * j]); }
    const LAS unsigned char* vp = lds + L_V + buf * 8192 + ((r32 >> 4) & 1) * 32 + (r32 & 3) * 8 + (4 * hi + ((r32 & 15) >> 2)) * 64;
#pragma unroll
    for (int d0 = 0; d0 < 2; ++d0)
#pragma unroll
        for (int ks = 0; ks < 4; ++ks) {
            const s16x4 lo = vtr(vp + d0 * 4096 + ks * 1024), hh = vtr(vp + d0 * 4096 + ks * 1024 + 512);
            const bf16x8 vf = (bf16x8){lo[0], lo[1], lo[2], lo[3], hh[0], hh[1], hh[2], hh[3]};
            o[d0] = __builtin_amdgcn_mfma_f32_32x32x16_bf16(__builtin_bit_cast(bf16x8, pw[ks]), vf, o[d0], 0, 0, 0);
        }
}

__device__ __forceinline__ void attn_unit(LAS unsigned char* lds, int b, int h, int qb, float bound_nat, const bf16* QF, const bf16* KF, const bf16* VF, const float* CUMF, bf16* YMIX) {
    const int tid = threadIdx.x, lane = tid & 63, r32 = lane & 31, hi = lane >> 5, wid = __builtin_amdgcn_readfirstlane(tid >> 6);
    const size_t rowbase = (size_t)b * SEQ; const int q0 = qb * 256;
    const float* Cc = CUMF + rowbase * 8 + h;
    const float cref = Cc[(size_t)q0 * 8];
    const int NT = (q0 + 256) / 64;
    int pred = 0;
    if (tid < NT - 4) pred = (Cc[(size_t)(64 * tid + 63) * 8] - cref) > bound_nat;
    const int t_stop = __syncthreads_count(pred);
    bf16x8 qr[4];
    { const bf16* Qw = QF + (rowbase + q0 + wid * 32 + r32) * 512 + h * 64 + hi * 8;
#pragma unroll
      for (int d0 = 0; d0 < 4; ++d0) qr[d0] = *(const bf16x8*)(Qw + d0 * 16); }
    const bf16* ksrc = KF + (rowbase + (tid & 63)) * 512 + h * 64 + (tid >> 6) * 8;
    const bf16* vsrc = VF + (rowbase + 16 * (wid & 3) + (lane >> 2)) * 512 + h * 64 + (wid >> 2) * 32 + (lane & 3) * 8;
    LAS float* wsf = (LAS float*)(lds + L_WS) + wid * 64;
    float m_run = -1e30f, l_run = 0.f; f32x16 o[2];
#pragma unroll
    for (int r = 0; r < 16; ++r) { o[0][r] = 0.f; o[1][r] = 0.f; }
    const int qlo = q0 + wid * 32, qg = qlo + r32;
    u32x4 kreg, vreg; float creg = 0.f;
    { const int t = NT - 1; kreg = *(const u32x4*)(ksrc + (size_t)t * 64 * 512); vreg = *(const u32x4*)(vsrc + (size_t)t * 64 * 512); if (tid < 64) creg = -(Cc[(size_t)(64 * t + tid) * 8] - cref) * LOG2E; }
    *(LAS u32x4*)(lds + L_K + tid * 16) = kreg; *(LAS u32x4*)(lds + L_V + tid * 16) = vreg; if (tid < 64) *(LAS float*)(lds + L_C + tid * 4) = creg;
    __syncthreads();
    int buf = 0;
    for (int t = NT - 1; t >= t_stop; --t) {
        const bool has_next = (t - 1 >= t_stop);
        if (has_next) { kreg = *(const u32x4*)(ksrc + (size_t)(t - 1) * 64 * 512); vreg = *(const u32x4*)(vsrc + (size_t)(t - 1) * 64 * 512); if (tid < 64) creg = -(Cc[(size_t)(64 * (t - 1) + tid) * 8] - cref) * LOG2E; }
        const int kv0 = 64 * t;
        if (kv0 <= qlo + 31) {
            if (kv0 + 63 > qlo) tile_step<true>(lds, buf, qr, o, m_run, l_run, wsf, r32, hi, kv0, qg);
            else tile_step<false>(lds, buf, qr, o, m_run, l_run, wsf, r32, hi, kv0, qg);
        }
        if (has_next) { *(LAS u32x4*)(lds + L_K + (buf ^ 1) * 8192 + tid * 16) = kreg; *(LAS u32x4*)(lds + L_V + (buf ^ 1) * 8192 + tid * 16) = vreg; if (tid < 64) *(LAS float*)(lds + L_C + (buf ^ 1) * 256 + tid * 4) = creg; }
        __syncthreads();
        buf ^= 1;
    }
    { auto rr = __builtin_amdgcn_permlane32_swap(__float_as_uint(l_run), __float_as_uint(l_run), false, false); l_run = __uint_as_float(rr[0]) + __uint_as_float(rr[1]); }
    if (hi == 0) wsf[32 + r32] = l_run;
    asm volatile("s_waitcnt lgkmcnt(0)" ::: "memory");
    LAS bf16* stg = (LAS bf16*)(lds + L_OST) + wid * 2048;
#pragma unroll
    for (int r = 0; r < 16; ++r) { const int orow = crow(r, hi); const float rl = __builtin_amdgcn_rcpf(wsf[32 + orow]);
        stg[orow * 64 + r32] = (bf16)f2bf(o[0][r] * rl); stg[orow * 64 + 32 + r32] = (bf16)f2bf(o[1][r] * rl); }
    asm volatile("s_waitcnt lgkmcnt(0)" ::: "memory");
    bf16* Ow = YMIX + (rowbase + q0 + wid * 32) * DM + 512 + h * 64;
#pragma unroll
    for (int i = 0; i < 4; ++i) { const int row = i * 8 + (lane >> 3), ch = lane & 7; *(u32x4*)(Ow + (size_t)row * DM + ch * 8) = *(const LAS u32x4*)(stg + row * 64 + ch * 8); }
    __syncthreads();
}
}

__device__ __forceinline__ void ph4_attn_mfma(const CParams& p, LAS unsigned char* ldsb) {
    const int lane = threadIdx.x & 63;
    float a = fabsf(p.in[15][lane]), k = fabsf(p.in[16][lane]);
#pragma unroll
    for (int o = 1; o < 64; o <<= 1) { a = fmaxf(a, __shfl_xor(a, o)); k = fmaxf(k, __shfl_xor(k, o)); }
    const float bound_nat = fox::THRESH + 2.f * 1.02f * 8.f * a * k;
    unsigned* q = (unsigned*)(p.ws + WS_CTL) + CW_AQ;
    LAS unsigned* nxt = (LAS unsigned*)(ldsb + 140000);
    const bf16* QF = (const bf16*)(p.ws + WS_QF); const bf16* KF = (const bf16*)(p.ws + WS_KF); const bf16* VF = (const bf16*)(p.ws + WS_VF);
    const float* CUMF = (const float*)(p.ws + WS_CUMF); bf16* YMIX = (bf16*)(p.ws + WS_YMIX);
    for (;;) {
        if (threadIdx.x == 0) *nxt = atomicAdd(q, 1u);
        __syncthreads();
        const unsigned u = *nxt;
        __syncthreads();
        if (u >= 1024u) break;
        const int qb = 31 - (int)(u >> 5), bh = (int)(u & 31u);
        fox::attn_unit(ldsb, bh >> 3, bh & 7, qb, bound_nat, QF, KF, VF, CUMF, YMIX);
    }
}

__device__ __forceinline__ float shifted(const bf16* PRW, const float* mu, size_t m, int c) {
    const float cur = bf2f(PRW[m * RW_COLS + c]);
    const float prev = ((m % SEQ) == 0) ? 0.f : bf2f(PRW[(m - 1) * RW_COLS + c]);
    return cur + (prev - cur) * mu[c];
}

namespace rws {
constexpr int NM = 16;
enum { M_CUM = 0, M_R, M_A, M_B, M_K, M_BH, M_KH, M_V, M_AAB, M_AAK, M_ARB, M_ARK, M_T, M_X1, M_W1, M_W2 };
__device__ __forceinline__ void smm(float (&z)[8], const float* X, int xi, int xk, const float* Y, int yj, int yk) {
    const int i = threadIdx.x >> 3, j0 = (threadIdx.x & 7) * 8;
#pragma unroll 2
    for (int k = 0; k < 64; ++k) { const float x = X[i * xi + k * xk];
#pragma unroll
        for (int e = 0; e < 8; ++e) z[e] += x * Y[(j0 + e) * yj + k * yk]; }
}
__device__ __forceinline__ void zero8(float (&z)[8]) {
#pragma unroll
    for (int e = 0; e < 8; ++e) z[e] = 0.f; }
}

__device__ __forceinline__ void rw_b1_slow(const CParams& p, float* lds) {
    using namespace rws;
    const int tid = threadIdx.x; int t = tid >> 3, sub = tid & 7, c0 = sub * 8;
    const int bh = blockIdx.x >> 3, b = bh >> 3, h = bh & 7;
    const bf16* PRW = (const bf16*)(p.ws + WS_PRW); const float* mu = p.in[3];
    float* scr0 = (float*)(p.ws + WS_SCR) + (size_t)blockIdx.x * NM * 4096;
    float* Xs = lds;
    float* Wl = lds + 16384;
    float* Ts = lds;
    for (int i = tid; i < 4096; i += NTHREADS) { Wl[i] = p.in[5][(size_t)(i >> 6) * 512 + h * 64 + (i & 63)]; Wl[4096 + i] = p.in[7][(size_t)(i >> 6) * 512 + h * 64 + (i & 63)]; }
    for (int i = tid; i < 8192; i += NTHREADS) Wl[8192 + i] = p.in[8][(size_t)(i >> 6) * 512 + h * 64 + (i & 63)];
#pragma nounroll
    for (int ci = 0; ci < 16; ++ci) {
        float* scr = scr0; asm volatile("" : "+s"(scr), "+v"(t), "+v"(sub)); c0 = sub * 8;
        const int chunk = (blockIdx.x & 7) * 16 + ci; const int unit = bh * 128 + chunk; const size_t m0 = (size_t)b * SEQ + chunk * 64, m = m0 + t;
        __syncthreads(); asm volatile("" : "+s"(scr), "+v"(t), "+v"(sub)); c0 = sub * 8;
#pragma unroll 2
        for (int i = 0; i < 32; ++i) { const int c = sub * 32 + i; const int col = c < 64 ? C_PW + c : (c < 128 ? C_PA + (c - 64) : C_PG + (c - 128));
            float v = shifted(PRW, mu, m, col); v = c < 64 ? tanhf(v) : (c < 128 ? v : sigmoidf_(v)); Xs[t * 256 + c] = v; }
        __syncthreads(); asm volatile("" : "+s"(scr), "+v"(t), "+v"(sub)); c0 = sub * 8;
        float accw[8], acca[8], accg[8];
        zero8(accw); zero8(acca); zero8(accg);
#pragma unroll 2
        for (int j = 0; j < 64; ++j) { const float xw = Xs[t * 256 + j], xa = Xs[t * 256 + 64 + j];
#pragma unroll
            for (int e = 0; e < 8; ++e) { accw[e] += xw * Wl[j * 64 + c0 + e]; acca[e] += xa * Wl[4096 + j * 64 + c0 + e]; } }
#pragma unroll 2
        for (int j = 0; j < 128; ++j) { const float xg = Xs[t * 256 + 128 + j];
#pragma unroll
            for (int e = 0; e < 8; ++e) accg[e] += xg * Wl[8192 + j * 64 + c0 + e]; }
        float nrm = 0.f, bon = 0.f; float kkv[8], kmod[8], al[8], rr[8];
#pragma unroll
        for (int e = 0; e < 8; ++e) { const int c = h * 64 + c0 + e;
            const float kraw = shifted(PRW, mu, m, C_K + c); rr[e] = shifted(PRW, mu, m, C_R + c);
            al[e] = sigmoidf_(p.in[6][c] + acca[e]); kkv[e] = kraw * p.in[9][c]; nrm += kkv[e] * kkv[e];
            kmod[e] = kraw * (1.f + (al[e] - 1.f) * p.in[10][c]); bon += rr[e] * kmod[e] * p.in[11][c];
            scr[M_CUM * 4096 + t * 64 + c0 + e] = -__expf(-softplusf_(-(p.in[4][c] + accw[e])) - 0.5f);
            scr[M_V * 4096 + t * 64 + c0 + e] = shifted(PRW, mu, m, C_V + c); }
        nrm += __shfl_xor(nrm, 1); nrm += __shfl_xor(nrm, 2); nrm += __shfl_xor(nrm, 4);
        bon += __shfl_xor(bon, 1); bon += __shfl_xor(bon, 2); bon += __shfl_xor(bon, 4);
        const float inv = 1.f / fmaxf(sqrtf(nrm), 1e-12f);
#pragma unroll
        for (int e = 0; e < 8; ++e) { const float kk = kkv[e] * inv;
            scr[M_R * 4096 + t * 64 + c0 + e] = rr[e]; scr[M_K * 4096 + t * 64 + c0 + e] = kmod[e]; scr[M_A * 4096 + t * 64 + c0 + e] = -kk; scr[M_B * 4096 + t * 64 + c0 + e] = kk * al[e]; }
        { bf16* GT = (bf16*)(p.ws + WS_GT) + (size_t)unit * 4096 + t * 64 + c0;
          *(u32x4*)GT = (u32x4){pk2(accg[0], accg[1]), pk2(accg[2], accg[3]), pk2(accg[4], accg[5]), pk2(accg[6], accg[7])};
          if (sub == 0) ((float*)(p.ws + WS_BON))[(size_t)unit * 64 + t] = bon; }
        __syncthreads(); asm volatile("" : "+s"(scr), "+v"(t), "+v"(sub)); c0 = sub * 8;
        if (tid < 64) { float run = 0.f; for (int tt = 0; tt < 64; ++tt) { run += scr[M_CUM * 4096 + tt * 64 + tid]; scr[M_CUM * 4096 + tt * 64 + tid] = run; } }
        __syncthreads(); asm volatile("" : "+s"(scr), "+v"(t), "+v"(sub)); c0 = sub * 8;
#pragma unroll
        for (int e = 0; e < 8; ++e) { const int c = c0 + e; const float cum = scr[M_CUM * 4096 + t * 64 + c], cumC = scr[M_CUM * 4096 + 63 * 64 + c];
            const float cum1 = t > 0 ? scr[M_CUM * 4096 + (t - 1) * 64 + c] : 0.f;
            const float bv = scr[M_B * 4096 + t * 64 + c], kv = scr[M_K * 4096 + t * 64 + c];
            scr[M_R * 4096 + t * 64 + c] *= __expf(cum); scr[M_A * 4096 + t * 64 + c] *= __expf(cum1);
            scr[M_BH * 4096 + t * 64 + c] = bv * __expf(cumC - cum); scr[M_KH * 4096 + t * 64 + c] = kv * __expf(cumC - cum);
            scr[M_B * 4096 + t * 64 + c] = bv * __expf(-cum); scr[M_K * 4096 + t * 64 + c] = kv * __expf(-cum); }
        __syncthreads(); asm volatile("" : "+s"(scr), "+v"(t), "+v"(sub)); c0 = sub * 8;
        { float z[8];
          zero8(z); smm(z, scr + M_A * 4096, 64, 1, scr + M_B * 4096, 64, 1);
#pragma unroll
          for (int e = 0; e < 8; ++e) scr[M_AAB * 4096 + t * 64 + c0 + e] = (c0 + e < t) ? z[e] : 0.f;
          zero8(z); smm(z, scr + M_A * 4096, 64, 1, scr + M_K * 4096, 64, 1);
#pragma unroll
          for (int e = 0; e < 8; ++e) scr[M_AAK * 4096 + t * 64 + c0 + e] = (c0 + e < t) ? z[e] : 0.f;
          zero8(z); smm(z, scr + M_R * 4096, 64, 1, scr + M_B * 4096, 64, 1);
#pragma unroll
          for (int e = 0; e < 8; ++e) scr[M_ARB * 4096 + t * 64 + c0 + e] = (c0 + e <= t) ? z[e] : 0.f;
          zero8(z); smm(z, scr + M_R * 4096, 64, 1, scr + M_K * 4096, 64, 1);
#pragma unroll
          for (int e = 0; e < 8; ++e) scr[M_ARK * 4096 + t * 64 + c0 + e] = (c0 + e <= t) ? z[e] : 0.f; }
        __syncthreads(); asm volatile("" : "+s"(scr), "+v"(t), "+v"(sub)); c0 = sub * 8;
        if (tid < 64) { for (int r = 0; r < 64; ++r) { float acc = (r == tid) ? 1.f : 0.f; for (int j = 0; j < r; ++j) acc += scr[M_AAB * 4096 + r * 64 + j] * Ts[j * 65 + tid]; Ts[r * 65 + tid] = acc; } }
        __syncthreads(); asm volatile("" : "+s"(scr), "+v"(t), "+v"(sub)); c0 = sub * 8;
#pragma unroll
        for (int e = 0; e < 8; ++e) scr[M_T * 4096 + t * 64 + c0 + e] = Ts[t * 65 + c0 + e];
        { float z[8]; zero8(z); smm(z, scr + M_AAK * 4096, 64, 1, scr + M_V * 4096, 1, 64);
#pragma unroll
          for (int e = 0; e < 8; ++e) scr[M_X1 * 4096 + t * 64 + c0 + e] = z[e]; }
        __syncthreads(); asm volatile("" : "+s"(scr), "+v"(t), "+v"(sub)); c0 = sub * 8;
        { float z[8]; zero8(z); smm(z, scr + M_T * 4096, 64, 1, scr + M_A * 4096, 1, 64);
#pragma unroll
          for (int e = 0; e < 8; ++e) scr[M_W1 * 4096 + t * 64 + c0 + e] = z[e];
          zero8(z); smm(z, scr + M_T * 4096, 64, 1, scr + M_X1 * 4096, 1, 64);
#pragma unroll
          for (int e = 0; e < 8; ++e) scr[M_W2 * 4096 + t * 64 + c0 + e] = z[e]; }
        __syncthreads(); asm volatile("" : "+s"(scr), "+v"(t), "+v"(sub)); c0 = sub * 8;
        { float z[8]; const int i = t;
          bf16* PQ = (bf16*)(p.ws + WS_PQ) + (size_t)unit * 8192; bf16* GY = (bf16*)(p.ws + WS_GY) + (size_t)unit * 8192;
          zero8(z); smm(z, scr + M_BH * 4096, 1, 64, scr + M_W1 * 4096, 1, 64);
#pragma unroll
          for (int e = 0; e < 8; ++e) if (c0 + e == i) z[e] += __expf(scr[M_CUM * 4096 + 63 * 64 + i]);
          *(u32x4*)(PQ + i * 64 + c0) = (u32x4){pk2(z[0], z[1]), pk2(z[2], z[3]), pk2(z[4], z[5]), pk2(z[6], z[7])};
          zero8(z); smm(z, scr + M_BH * 4096, 1, 64, scr + M_W2 * 4096, 1, 64); smm(z, scr + M_KH * 4096, 1, 64, scr + M_V * 4096, 1, 64);
#pragma unroll
          for (int e = 0; e < 8; ++e) PQ[4096 + (c0 + e) * 64 + i] = (bf16)f2bf(z[e]);
          zero8(z); smm(z, scr + M_ARB * 4096, 64, 1, scr + M_W1 * 4096, 1, 64);
#pragma unroll
          for (int e = 0; e < 8; ++e) z[e] += scr[M_R * 4096 + i * 64 + c0 + e];
          *(u32x4*)(GY + i * 64 + c0) = (u32x4){pk2(z[0], z[1]), pk2(z[2], z[3]), pk2(z[4], z[5]), pk2(z[6], z[7])};
          zero8(z); smm(z, scr + M_ARB * 4096, 64, 1, scr + M_W2 * 4096, 1, 64); smm(z, scr + M_ARK * 4096, 64, 1, scr + M_V * 4096, 1, 64);
#pragma unroll
          for (int e = 0; e < 8; ++e) GY[4096 + (c0 + e) * 64 + i] = (bf16)f2bf(z[e]); }
    }
}

__device__ __forceinline__ void rw_b2_slow(const CParams& p, float* lds) {
    if (blockIdx.x >= 32) return;
    const int tid = threadIdx.x, i = tid >> 3, j0 = (tid & 7) * 8, bh = blockIdx.x;
    float* Ss = lds;
    for (int k = tid; k < 64 * 65; k += NTHREADS) Ss[k] = 0.f;
    for (int chunk = 0; chunk < 128; ++chunk) {
        const int unit = bh * 128 + chunk;
        const bf16* PQ = (const bf16*)(p.ws + WS_PQ) + (size_t)unit * 8192; bf16* S0 = (bf16*)(p.ws + WS_S0) + (size_t)unit * 4096;
        __syncthreads();
        { float s[8];
#pragma unroll
          for (int e = 0; e < 8; ++e) s[e] = Ss[(j0 + e) * 65 + i];
          *(u32x4*)(S0 + i * 64 + j0) = (u32x4){pk2(s[0], s[1]), pk2(s[2], s[3]), pk2(s[4], s[5]), pk2(s[6], s[7])}; }
        float z[8];
#pragma unroll
        for (int e = 0; e < 8; ++e) z[e] = bf2f(PQ[4096 + (j0 + e) * 64 + i]);
        for (int c = 0; c < 64; ++c) { const float pv = bf2f(PQ[i * 64 + c]);
#pragma unroll
            for (int e = 0; e < 8; ++e) z[e] += pv * Ss[c * 65 + j0 + e]; }
        __syncthreads();
#pragma unroll
        for (int e = 0; e < 8; ++e) Ss[i * 65 + j0 + e] = z[e];
    }
}

__device__ __forceinline__ void rw_b3_slow(const CParams& p) {
    const int tid = threadIdx.x, t = tid >> 3, v0 = (tid & 7) * 8;
    const bf16* PRW = (const bf16*)(p.ws + WS_PRW); const float* mu = p.in[3]; bf16* YMIX = (bf16*)(p.ws + WS_YMIX);
    for (int unit = blockIdx.x; unit < 4096; unit += gridDim.x) {
        const int bh = unit >> 7, chunk = unit & 127, b = bh >> 3, h = bh & 7; const size_t m = (size_t)b * SEQ + chunk * 64 + t;
        const bf16* GY = (const bf16*)(p.ws + WS_GY) + (size_t)unit * 8192; const bf16* S0 = (const bf16*)(p.ws + WS_S0) + (size_t)unit * 4096;
        const bf16* GT = (const bf16*)(p.ws + WS_GT) + (size_t)unit * 4096;
        float y[8];
#pragma unroll
        for (int e = 0; e < 8; ++e) y[e] = bf2f(GY[4096 + (v0 + e) * 64 + t]);
        for (int c = 0; c < 64; ++c) { const float g = bf2f(GY[t * 64 + c]);
#pragma unroll
            for (int e = 0; e < 8; ++e) y[e] += g * bf2f(S0[(v0 + e) * 64 + c]); }
        float s = 0.f;
#pragma unroll
        for (int e = 0; e < 8; ++e) s += y[e];
        s += __shfl_xor(s, 1); s += __shfl_xor(s, 2); s += __shfl_xor(s, 4);
        const float mean = s * (1.f / 64.f); float q = 0.f;
#pragma unroll
        for (int e = 0; e < 8; ++e) { y[e] -= mean; q += y[e] * y[e]; }
        q += __shfl_xor(q, 1); q += __shfl_xor(q, 2); q += __shfl_xor(q, 4);
        const float rstd = rsqrtf(q * (1.f / 64.f) + 64e-5f), bon = ((const float*)(p.ws + WS_BON))[(size_t)unit * 64 + t];
        float o[8];
#pragma unroll
        for (int e = 0; e < 8; ++e) { const int c = h * 64 + v0 + e; o[e] = (y[e] * rstd * p.in[12][c] + p.in[13][c] + bon * shifted(PRW, mu, m, C_V + c)) * bf2f(GT[t * 64 + v0 + e]); }
        *(u32x4*)(YMIX + m * DM + h * 64 + v0) = (u32x4){pk2(o[0], o[1]), pk2(o[2], o[3]), pk2(o[4], o[5]), pk2(o[6], o[7])};
    }
}

namespace rwf {
typedef short bf16x8 __attribute__((ext_vector_type(8)));
__device__ __forceinline__ unsigned cvtpk(float lo, float hi) { return cvtpk_c(lo, hi); }
__device__ __forceinline__ f32x4 bf4_to_f32(u32x2 v) { return (f32x4){__uint_as_float(v.x << 16), __uint_as_float(v.x & 0xffff0000u), __uint_as_float(v.y << 16), __uint_as_float(v.y & 0xffff0000u)}; }
}
__device__ __forceinline__ void rw_b2_fast(const CParams& p) {
    using namespace rwf;
    if (blockIdx.x >= 32) return;
    const int wid = __builtin_amdgcn_readfirstlane(threadIdx.x >> 6); if (wid >= 4) return;
    const int lane = threadIdx.x & 63, fr = lane & 15, fq = lane >> 4, bh = blockIdx.x;
    f32x4 acc[4];
#pragma unroll
    for (int m = 0; m < 4; ++m) acc[m] = (f32x4){0.f, 0.f, 0.f, 0.f};
    const bf16* PQ0 = (const bf16*)(p.ws + WS_PQ) + (size_t)bh * 128 * 8192; bf16* S00 = (bf16*)(p.ws + WS_S0) + (size_t)bh * 128 * 4096;
    const int poff = fr * 64 + 4 * fq;
    const int qoff = 4096 + (16 * wid + fr) * 64 + 4 * fq;
    u32x2 pa[4][2][2], qc[4];
#define RWB2_LOAD(chunk) do { const bf16* pq_ = PQ0 + (size_t)(chunk) * 8192; _Pragma("unroll") for (int m_ = 0; m_ < 4; ++m_) { qc[m_] = *(const u32x2*)(pq_ + qoff + 16 * m_); \
        _Pragma("unroll") for (int s_ = 0; s_ < 2; ++s_) { pa[m_][s_][0] = *(const u32x2*)(pq_ + poff + m_ * 1024 + 32 * s_); pa[m_][s_][1] = *(const u32x2*)(pq_ + poff + m_ * 1024 + 32 * s_ + 16); } } } while (0)
    RWB2_LOAD(0);
    for (int chunk = 0; chunk < 128; ++chunk) {
        bf16x8 bfr[2];
        { u32x2 lo[4];
#pragma unroll
          for (int m = 0; m < 4; ++m) lo[m] = (u32x2){cvtpk(acc[m][0], acc[m][1]), cvtpk(acc[m][2], acc[m][3])};
          bf16* s0 = S00 + (size_t)chunk * 4096 + (16 * wid + fr) * 64 + 4 * fq;
#pragma unroll
          for (int m = 0; m < 4; ++m) *(u32x2*)(s0 + 16 * m) = lo[m];
          bfr[0] = __builtin_bit_cast(bf16x8, (u32x4){lo[0].x, lo[0].y, lo[1].x, lo[1].y}); bfr[1] = __builtin_bit_cast(bf16x8, (u32x4){lo[2].x, lo[2].y, lo[3].x, lo[3].y}); }
        bf16x8 af[4][2]; f32x4 cin[4];
#pragma unroll
        for (int m = 0; m < 4; ++m) { cin[m] = bf4_to_f32(qc[m]);
#pragma unroll
            for (int s = 0; s < 2; ++s) af[m][s] = __builtin_bit_cast(bf16x8, (u32x4){pa[m][s][0].x, pa[m][s][0].y, pa[m][s][1].x, pa[m][s][1].y}); }
        if (chunk + 1 < 128) RWB2_LOAD(chunk + 1);
#pragma unroll
        for (int m = 0; m < 4; ++m) { f32x4 c = __builtin_amdgcn_mfma_f32_16x16x32_bf16(af[m][0], bfr[0], cin[m], 0, 0, 0); acc[m] = __builtin_amdgcn_mfma_f32_16x16x32_bf16(af[m][1], bfr[1], c, 0, 0, 0); }
    }
#undef RWB2_LOAD
}

__device__ __forceinline__ void rw_b3_fast(const CParams& p) {
    using namespace rwf;
    const int lane = threadIdx.x & 63, fr = lane & 15, fq = lane >> 4, wid = __builtin_amdgcn_readfirstlane(threadIdx.x >> 6);
    const bf16* PRW = (const bf16*)(p.ws + WS_PRW); const float* mu = p.in[3]; bf16* YMIX = (bf16*)(p.ws + WS_YMIX);
    for (int task = blockIdx.x * NWAVES + wid; task < 4096 * 4; task += gridDim.x * NWAVES) {
        const int unit = task >> 2, tt = task & 3, bh = unit >> 7, chunk = unit & 127, b = bh >> 3, h = bh & 7;
        const bf16* GY = (const bf16*)(p.ws + WS_GY) + (size_t)unit * 8192; const bf16* S0 = (const bf16*)(p.ws + WS_S0) + (size_t)unit * 4096; const bf16* GT = (const bf16*)(p.ws + WS_GT) + (size_t)unit * 4096;
        bf16x8 ga[2], sb[4][2]; f32x4 y[4];
#pragma unroll
        for (int s = 0; s < 2; ++s) ga[s] = *(const bf16x8*)(GY + (16 * tt + fr) * 64 + 32 * s + 8 * fq);
#pragma unroll
        for (int vt = 0; vt < 4; ++vt) { y[vt] = bf4_to_f32(*(const u32x2*)(GY + 4096 + (16 * vt + fr) * 64 + 16 * tt + 4 * fq));
#pragma unroll
            for (int s = 0; s < 2; ++s) sb[vt][s] = *(const bf16x8*)(S0 + (16 * vt + fr) * 64 + 32 * s + 8 * fq); }
#pragma unroll
        for (int vt = 0; vt < 4; ++vt) { y[vt] = __builtin_amdgcn_mfma_f32_16x16x32_bf16(ga[0], sb[vt][0], y[vt], 0, 0, 0); y[vt] = __builtin_amdgcn_mfma_f32_16x16x32_bf16(ga[1], sb[vt][1], y[vt], 0, 0, 0); }
        float mean[4], rstd[4];
#pragma unroll
        for (int i = 0; i < 4; ++i) { float s = (y[0][i] + y[1][i]) + (y[2][i] + y[3][i]);
            s += __shfl_xor(s, 1); s += __shfl_xor(s, 2); s += __shfl_xor(s, 4); s += __shfl_xor(s, 8); mean[i] = s * (1.f / 64.f);
            float q = 0.f;
#pragma unroll
            for (int vt = 0; vt < 4; ++vt) { const float d = y[vt][i] - mean[i]; q += d * d; }
            q += __shfl_xor(q, 1); q += __shfl_xor(q, 2); q += __shfl_xor(q, 4); q += __shfl_xor(q, 8); rstd[i] = rsqrtf(q * (1.f / 64.f) + 64e-5f); }
        const size_t m0 = (size_t)b * SEQ + chunk * 64 + 16 * tt + 4 * fq;
#pragma unroll
        for (int i = 0; i < 4; ++i) { const float bon = ((const float*)(p.ws + WS_BON))[(size_t)unit * 64 + 16 * tt + 4 * fq + i];
#pragma unroll
            for (int vt = 0; vt < 4; ++vt) { const int v = 16 * vt + fr, c = h * 64 + v;
                const float o = ((y[vt][i] - mean[i]) * rstd[i] * p.in[12][c] + p.in[13][c] + bon * shifted(PRW, mu, m0 + i, C_V + c)) * bf2f(GT[(16 * tt + 4 * fq + i) * 64 + v]);
                YMIX[(m0 + i) * DM + c] = (bf16)f2bf(o); } }
    }
}

namespace rwf {
constexpr int LS = 72, FS = 68;
constexpr int O_XW = 0, O_XA = 9216, O_XG = 18432;
constexpr int O_AAK = 0, O_ARB = 9216, O_ARK = 18432, O_TB = 27648;
constexpr int O_F1 = 36864, O_F2 = 54272;
constexpr int O_RT = 71680, O_AT = 80896, O_BT = 90112, O_KT = 99328, O_ATT = 108544, O_VTT = 117760, O_BHT = 126976, O_KHT = 136192;
constexpr int O_X1T = O_BT, O_W1T = O_KT, O_W2T = O_AT;
constexpr int O_GC = 145408;
__device__ __forceinline__ f32x4 mm2(const LAS unsigned char* X, int xrow, const LAS unsigned char* Y, int yrow, f32x4 c, int fq) {
#pragma unroll
    for (int s = 0; s < 2; ++s) { const bf16x8 a = *(const LAS bf16x8*)(X + xrow * (LS * 2) + 64 * s + 16 * fq), b = *(const LAS bf16x8*)(Y + yrow * (LS * 2) + 64 * s + 16 * fq);
        c = __builtin_amdgcn_mfma_f32_16x16x32_bf16(a, b, c, 0, 0, 0); }
    return c;
}
__device__ __forceinline__ void unpack8(u32x4 v, float (&f)[8]) {
    f[0] = __uint_as_float(v.x << 16); f[1] = __uint_as_float(v.x & 0xffff0000u); f[2] = __uint_as_float(v.y << 16); f[3] = __uint_as_float(v.y & 0xffff0000u);
    f[4] = __uint_as_float(v.z << 16); f[5] = __uint_as_float(v.z & 0xffff0000u); f[6] = __uint_as_float(v.w << 16); f[7] = __uint_as_float(v.w & 0xffff0000u); }
__device__ __forceinline__ u32x4 pack8(const float (&f)[8]) { return (u32x4){cvtpk(f[0], f[1]), cvtpk(f[2], f[3]), cvtpk(f[4], f[5]), cvtpk(f[6], f[7])}; }
__device__ __forceinline__ void shifted8(const bf16* PRW, const float* mu, size_t m, int col, float (&o)[8]) {
    float cur[8], prv[8];
    unpack8(*(const u32x4*)(PRW + m * RW_COLS + col), cur);
    if ((m % SEQ) != 0) unpack8(*(const u32x4*)(PRW + (m - 1) * RW_COLS + col), prv); else {
#pragma unroll
        for (int e = 0; e < 8; ++e) prv[e] = 0.f; }
    const f32x4 m0 = *(const f32x4*)(mu + col), m1 = *(const f32x4*)(mu + col + 4); const float mm[8] = {m0.x, m0.y, m0.z, m0.w, m1.x, m1.y, m1.z, m1.w};
#pragma unroll
    for (int e = 0; e < 8; ++e) o[e] = cur[e] + (prv[e] - cur[e]) * mm[e];
}
}

__device__ __forceinline__ void rw_b1_fast(const CParams& p, LAS unsigned char* lds) {
    using namespace rwf;
    const int wid = __builtin_amdgcn_readfirstlane(threadIdx.x >> 6);
    const bf16* PRW = (const bf16*)(p.ws + WS_PRW); const float* mu = p.in[3];
    const bf16* W2T = (const bf16*)(p.ws + WS_LORA); const bf16* A2T = W2T + 512 * 64; const bf16* G2T = A2T + 512 * 64;
    LAS float* F1 = (LAS float*)(lds + O_F1); LAS float* F2 = (LAS float*)(lds + O_F2); LAS float* GC = (LAS float*)(lds + O_GC);
#pragma nounroll
    for (int unit = blockIdx.x; unit < 4096; unit += gridDim.x) {
        int tid = threadIdx.x; asm volatile("" : "+v"(tid));
        const int lane = tid & 63, fr = lane & 15, fq = lane >> 4, t = tid >> 3, sub = tid & 7, c0 = sub * 8;
        const int bh = unit >> 7, chunk = unit & 127, b = bh >> 3, h = bh & 7; const size_t m = (size_t)b * SEQ + chunk * 64 + t;
        float r[8], kraw[8], v[8];
        shifted8(PRW, mu, m, C_R + h * 64 + c0, r); shifted8(PRW, mu, m, C_K + h * 64 + c0, kraw); shifted8(PRW, mu, m, C_V + h * 64 + c0, v);
        { float x[8];
          shifted8(PRW, mu, m, C_PW + c0, x);
#pragma unroll
          for (int e = 0; e < 8; ++e) x[e] = tanhf(x[e]);
          *(LAS u32x4*)(lds + O_XW + t * (LS * 2) + c0 * 2) = pack8(x);
          shifted8(PRW, mu, m, C_PA + c0, x);
          *(LAS u32x4*)(lds + O_XA + t * (LS * 2) + c0 * 2) = pack8(x);
#pragma unroll
          for (int q = 0; q < 2; ++q) { shifted8(PRW, mu, m, C_PG + sub * 16 + 8 * q, x);
#pragma unroll
              for (int e = 0; e < 8; ++e) x[e] = sigmoidf_(x[e]);
              *(LAS u32x4*)(lds + O_XG + t * 272 + sub * 32 + 16 * q) = pack8(x); } }
        __syncthreads();
        { const int tt = wid & 3;
#pragma unroll
          for (int q = 0; q < 2; ++q) { const int ct = 2 * (wid >> 2) + q, crow = h * 64 + 16 * ct + fr;
              f32x4 dw = (f32x4){0.f, 0.f, 0.f, 0.f}, da = dw, dg = dw;
#pragma unroll
              for (int s = 0; s < 2; ++s) {
                  const bf16x8 xw = *(const LAS bf16x8*)(lds + O_XW + (16 * tt + fr) * (LS * 2) + 64 * s + 16 * fq), xa = *(const LAS bf16x8*)(lds + O_XA + (16 * tt + fr) * (LS * 2) + 64 * s + 16 * fq);
                  dw = __builtin_amdgcn_mfma_f32_16x16x32_bf16(*(const bf16x8*)(W2T + crow * 64 + 32 * s + 8 * fq), xw, dw, 0, 0, 0);
                  da = __builtin_amdgcn_mfma_f32_16x16x32_bf16(*(const bf16x8*)(A2T + crow * 64 + 32 * s + 8 * fq), xa, da, 0, 0, 0); }
#pragma unroll
              for (int s = 0; s < 4; ++s) { const bf16x8 xg = *(const LAS bf16x8*)(lds + O_XG + (16 * tt + fr) * 272 + 64 * s + 16 * fq);
                  dg = __builtin_amdgcn_mfma_f32_16x16x32_bf16(*(const bf16x8*)(G2T + crow * 128 + 32 * s + 8 * fq), xg, dg, 0, 0, 0); }
              const int tok = 16 * tt + fr, cc = 16 * ct + 4 * fq;
              *(LAS f32x4*)(F1 + tok * FS + cc) = dw; *(LAS f32x4*)(F2 + tok * FS + cc) = da;
              *(u32x2*)((bf16*)(p.ws + WS_GT) + (size_t)unit * 4096 + tok * 64 + cc) = (u32x2){cvtpk(dg[0], dg[1]), cvtpk(dg[2], dg[3])}; } }
        __syncthreads();
        float ld[8], av[8], bv[8], kmod[8];
        { const f32x4 w0a = *(const LAS f32x4*)(F1 + t * FS + c0), w0b = *(const LAS f32x4*)(F1 + t * FS + c0 + 4), a0a = *(const LAS f32x4*)(F2 + t * FS + c0), a0b = *(const LAS f32x4*)(F2 + t * FS + c0 + 4);
          const float wl[8] = {w0a.x, w0a.y, w0a.z, w0a.w, w0b.x, w0b.y, w0b.z, w0b.w}, al_[8] = {a0a.x, a0a.y, a0a.z, a0a.w, a0b.x, a0b.y, a0b.z, a0b.w};
          float nrm = 0.f, bon = 0.f, kkv[8], alp[8];
#pragma unroll
          for (int e = 0; e < 8; ++e) { const int c = h * 64 + c0 + e;
              ld[e] = -__expf(-softplusf_(-(p.in[4][c] + wl[e])) - 0.5f);
              alp[e] = sigmoidf_(p.in[6][c] + al_[e]); kkv[e] = kraw[e] * p.in[9][c]; nrm += kkv[e] * kkv[e];
              kmod[e] = kraw[e] * (1.f + (alp[e] - 1.f) * p.in[10][c]); bon += r[e] * kmod[e] * p.in[11][c]; }
          nrm += __shfl_xor(nrm, 1); nrm += __shfl_xor(nrm, 2); nrm += __shfl_xor(nrm, 4);
          bon += __shfl_xor(bon, 1); bon += __shfl_xor(bon, 2); bon += __shfl_xor(bon, 4);
          const float inv = 1.f / fmaxf(sqrtf(nrm), 1e-12f);
#pragma unroll
          for (int e = 0; e < 8; ++e) { const float kk = kkv[e] * inv; av[e] = -kk; bv[e] = kk * alp[e]; }
          *(LAS f32x4*)(F1 + t * FS + c0) = (f32x4){ld[0], ld[1], ld[2], ld[3]}; *(LAS f32x4*)(F1 + t * FS + c0 + 4) = (f32x4){ld[4], ld[5], ld[6], ld[7]};
          if (sub == 0) ((float*)(p.ws + WS_BON))[(size_t)unit * 64 + t] = bon; }
        __syncthreads();
        { float pv[8], run = 0.f;
#pragma unroll
          for (int i = 0; i < 8; ++i) { run += F1[(8 * wid + i) * FS + lane]; pv[i] = run; }
          F2[wid * 64 + lane] = run;
          __syncthreads();
          float base = 0.f;
#pragma unroll
          for (int g = 0; g < 7; ++g) base += (g < wid) ? F2[g * 64 + lane] : 0.f;
#pragma unroll
          for (int i = 0; i < 8; ++i) F1[(8 * wid + i) * FS + lane] = base + pv[i]; }
        __syncthreads();
        { const f32x4 ca = *(const LAS f32x4*)(F1 + t * FS + c0), cb = *(const LAS f32x4*)(F1 + t * FS + c0 + 4), ea = *(const LAS f32x4*)(F1 + 63 * FS + c0), eb = *(const LAS f32x4*)(F1 + 63 * FS + c0 + 4);
          const float cum[8] = {ca.x, ca.y, ca.z, ca.w, cb.x, cb.y, cb.z, cb.w}, cumC[8] = {ea.x, ea.y, ea.z, ea.w, eb.x, eb.y, eb.z, eb.w};
          float rt[8], at[8], bt[8], kt[8];
#pragma unroll
          for (int e = 0; e < 8; ++e) { const float et = __expf(cum[e]), e1 = __expf(cum[e] - ld[e]), ei = __expf(-cum[e]), eC = __expf(cumC[e] - cum[e]);
              rt[e] = r[e] * et; at[e] = av[e] * e1; bt[e] = bv[e] * ei; kt[e] = kmod[e] * ei;
              const int c = c0 + e;
              *(LAS bf16*)(lds + O_ATT + c * (LS * 2) + t * 2) = (bf16)f2bf(at[e]);
              *(LAS bf16*)(lds + O_VTT + c * (LS * 2) + t * 2) = (bf16)f2bf(v[e]);
              *(LAS bf16*)(lds + O_BHT + c * (LS * 2) + t * 2) = (bf16)f2bf(bv[e] * eC);
              *(LAS bf16*)(lds + O_KHT + c * (LS * 2) + t * 2) = (bf16)f2bf(kmod[e] * eC);
              if (t == 63) GC[c] = __expf(cumC[e]); }
          *(LAS u32x4*)(lds + O_RT + t * (LS * 2) + c0 * 2) = pack8(rt); *(LAS u32x4*)(lds + O_AT + t * (LS * 2) + c0 * 2) = pack8(at);
          *(LAS u32x4*)(lds + O_BT + t * (LS * 2) + c0 * 2) = pack8(bt); *(LAS u32x4*)(lds + O_KT + t * (LS * 2) + c0 * 2) = pack8(kt); }
        __syncthreads();
#pragma unroll
        for (int q = 0; q < 2; ++q) { const int tile = wid + 8 * q, jt = tile >> 2, tt = tile & 3;
            const int tok = 16 * tt + fr, j0 = 16 * jt + 4 * fq;
            f32x4 dab = (f32x4){0.f, 0.f, 0.f, 0.f}, dak = dab, drb = dab, drk = dab;
            if (jt <= tt) {
                dab = mm2(lds + O_BT, 16 * jt + fr, lds + O_AT, tok, dab, fq); dak = mm2(lds + O_KT, 16 * jt + fr, lds + O_AT, tok, dak, fq);
                drb = mm2(lds + O_BT, 16 * jt + fr, lds + O_RT, tok, drb, fq); drk = mm2(lds + O_KT, 16 * jt + fr, lds + O_RT, tok, drk, fq);
#pragma unroll
                for (int i = 0; i < 4; ++i) { if (!(j0 + i < tok)) { dab[i] = 0.f; dak[i] = 0.f; } if (!(j0 + i <= tok)) { drb[i] = 0.f; drk[i] = 0.f; } } }
            *(LAS f32x4*)(F1 + tok * FS + j0) = dab;
            *(LAS u32x2*)(lds + O_AAK + tok * (LS * 2) + j0 * 2) = (u32x2){cvtpk(dak[0], dak[1]), cvtpk(dak[2], dak[3])};
            *(LAS u32x2*)(lds + O_ARB + tok * (LS * 2) + j0 * 2) = (u32x2){cvtpk(drb[0], drb[1]), cvtpk(drb[2], drb[3])};
            *(LAS u32x2*)(lds + O_ARK + tok * (LS * 2) + j0 * 2) = (u32x2){cvtpk(drk[0], drk[1]), cvtpk(drk[2], drk[3])}; }
        __syncthreads();
        if (wid == 0) {
            float tc[64];
#pragma unroll
            for (int rr = 0; rr < 64; ++rr) {
                float a0 = (rr == lane) ? 1.f : 0.f, a1 = 0.f, a2 = 0.f, a3 = 0.f;
#pragma unroll
                for (int g = 0; g < (rr + 3) / 4; ++g) { const f32x4 l4 = *(const LAS f32x4*)(F1 + rr * FS + 4 * g);
                    if (4 * g + 0 < rr) a0 += l4.x * tc[4 * g + 0]; if (4 * g + 1 < rr) a1 += l4.y * tc[4 * g + 1]; if (4 * g + 2 < rr) a2 += l4.z * tc[4 * g + 2]; if (4 * g + 3 < rr) a3 += l4.w * tc[4 * g + 3]; }
                tc[rr] = (a0 + a1) + (a2 + a3);
                *(LAS bf16*)(lds + O_TB + rr * (LS * 2) + lane * 2) = (bf16)f2bf(tc[rr]);
            }
        } else {
            for (int tile = wid - 1; tile < 16; tile += 7) { const int tt = tile >> 2, vt = tile & 3;
                f32x4 d = (f32x4){0.f, 0.f, 0.f, 0.f};
                d = mm2(lds + O_AAK, 16 * tt + fr, lds + O_VTT, 16 * vt + fr, d, fq);
                *(LAS u32x2*)(lds + O_X1T + (16 * vt + fr) * (LS * 2) + (16 * tt + 4 * fq) * 2) = (u32x2){cvtpk(d[0], d[1]), cvtpk(d[2], d[3])}; }
        }
        __syncthreads();
#pragma unroll
        for (int q = 0; q < 2; ++q) { const int tile = wid + 8 * q, tt = tile >> 2, xt = tile & 3;
            f32x4 d1 = (f32x4){0.f, 0.f, 0.f, 0.f}, d2 = d1;
            d1 = mm2(lds + O_TB, 16 * tt + fr, lds + O_ATT, 16 * xt + fr, d1, fq); d2 = mm2(lds + O_TB, 16 * tt + fr, lds + O_X1T, 16 * xt + fr, d2, fq);
            *(LAS u32x2*)(lds + O_W1T + (16 * xt + fr) * (LS * 2) + (16 * tt + 4 * fq) * 2) = (u32x2){cvtpk(d1[0], d1[1]), cvtpk(d1[2], d1[3])};
            *(LAS u32x2*)(lds + O_W2T + (16 * xt + fr) * (LS * 2) + (16 * tt + 4 * fq) * 2) = (u32x2){cvtpk(d2[0], d2[1]), cvtpk(d2[2], d2[3])}; }
        __syncthreads();
        { bf16* PQ = (bf16*)(p.ws + WS_PQ) + (size_t)unit * 8192; bf16* GY = (bf16*)(p.ws + WS_GY) + (size_t)unit * 8192;
#pragma unroll
          for (int q = 0; q < 2; ++q) { const int tile = wid + 8 * q, it = tile >> 2, jt = tile & 3;
              const int jj = 16 * jt + fr, i0 = 16 * it + 4 * fq;
              f32x4 d = (f32x4){0.f, 0.f, 0.f, 0.f};
              d = mm2(lds + O_W1T, 16 * it + fr, lds + O_BHT, jj, d, fq);
#pragma unroll
              for (int i = 0; i < 4; ++i) if (i0 + i == jj) d[i] += GC[jj];
              *(u32x2*)(PQ + jj * 64 + i0) = (u32x2){cvtpk(d[0], d[1]), cvtpk(d[2], d[3])};
              d = (f32x4){0.f, 0.f, 0.f, 0.f};
              d = mm2(lds + O_BHT, 16 * it + fr, lds + O_W2T, jj, d, fq); d = mm2(lds + O_KHT, 16 * it + fr, lds + O_VTT, jj, d, fq);
              *(u32x2*)(PQ + 4096 + jj * 64 + i0) = (u32x2){cvtpk(d[0], d[1]), cvtpk(d[2], d[3])};
              d = rwf::bf4_to_f32(*(const LAS u32x2*)(lds + O_RT + jj * (LS * 2) + i0 * 2));
              d = mm2(lds + O_W1T, 16 * it + fr, lds + O_ARB, jj, d, fq);
              *(u32x2*)(GY + jj * 64 + i0) = (u32x2){cvtpk(d[0], d[1]), cvtpk(d[2], d[3])};
              d = (f32x4){0.f, 0.f, 0.f, 0.f};
              d = mm2(lds + O_ARB, 16 * it + fr, lds + O_W2T, jj, d, fq); d = mm2(lds + O_ARK, 16 * it + fr, lds + O_VTT, jj, d, fq);
              *(u32x2*)(GY + 4096 + jj * 64 + i0) = (u32x2){cvtpk(d[0], d[1]), cvtpk(d[2], d[3])}; } }
        __syncthreads();
    }
}

struct EpiRes {
    static constexpr bool PERM = false;
    const float* x; float* out;
    __device__ __forceinline__ void operator()(const f32x4 (&acc)[2][2][4][2], const pg8::Unit& u, int wr, int wc, int fr, int fq, LAS unsigned char* lds) const {
        const int col0 = u.pn * 256 + wc * 32 + 4 * fq;
#pragma unroll
        for (int ai = 0; ai < 2; ++ai)
#pragma unroll
            for (int m = 0; m < 4; ++m) { const size_t off = (size_t)(u.pm * 256 + ai * 128 + wr * 64 + m * 16 + fr) * DM + col0;
#pragma unroll
                for (int bj = 0; bj < 2; ++bj)
#pragma unroll
                    for (int n = 0; n < 2; ++n) { const f32x4 xv = *(const f32x4*)(x + off + bj * 128 + n * 16); *(f32x4*)(out + off + bj * 128 + n * 16) = xv + acc[ai][bj][m][n]; } }
    }
};
__device__ __forceinline__ void ph8_wout(const CParams& p, LAS unsigned char* ldsb) {
    pg8::DenseOrder S; S.init(M, DM, DM, gridDim.x, blockIdx.x);
    EpiRes E{p.in[0], p.out};
    pg8::gemm_phase<EpiRes, pg8::DenseOrder, true, false>(ldsb, (const bf16*)(p.ws + WS_YMIX), (const bf16*)(p.ws + WS_WOUTT), DM, nullptr, S, E);
}

__device__ __forceinline__ void ph9_route(const CParams& p, float* lds) {
    const int lane = threadIdx.x & 63, wave = threadIdx.x >> 6;
    bf16* H2 = (bf16*)(p.ws + WS_H2); int* EID = (int*)(p.ws + WS_EID); float* GATE = (float*)(p.ws + WS_GATE); int* RANK = (int*)(p.ws + WS_RANK);
    int* CNT = (int*)(p.ws + WS_CTL) + CW_CNT;
    const float* nw = p.in[18]; const float* rgw = p.in[19]; const float* rgb = p.in[20]; const float* rew = p.in[21]; const float* reb = p.in[22];
    float* Hs = lds + wave * 1024;
    f32x4 w[4];
#pragma unroll
    for (int j = 0; j < 4; ++j) w[j] = ((const f32x4*)nw)[lane + 64 * j];
    for (int grp = blockIdx.x; grp < M / 8; grp += gridDim.x) {
        const size_t m = (size_t)grp * 8 + wave;
        const f32x4* xr = (const f32x4*)(p.out + m * DM) + lane;
        f32x4 v[4]; float s = 0.f;
#pragma unroll
        for (int j = 0; j < 4; ++j) { v[j] = xr[64 * j]; s += (v[j].x * v[j].x + v[j].y * v[j].y) + (v[j].z * v[j].z + v[j].w * v[j].w); }
        const float rstd = rsqrtf(wave_sum(s) * (1.f / DM) + 1e-6f);
        __syncthreads();
#pragma unroll
        for (int j = 0; j < 4; ++j) { const f32x4 hv = (f32x4){v[j].x * rstd * w[j].x, v[j].y * rstd * w[j].y, v[j].z * rstd * w[j].z, v[j].w * rstd * w[j].w};
            *(f32x4*)&Hs[(lane + 64 * j) * 4] = hv; ((u32x2*)(H2 + m * DM))[lane + 64 * j] = (u32x2){pk2(hv.x, hv.y), pk2(hv.z, hv.w)}; }
        __syncthreads();
        float el = 0.f, gl = 0.f;
#pragma unroll 8
        for (int k = 0; k < DM; ++k) { const float hk = Hs[k]; el += hk * rew[k * 64 + lane]; gl += hk * rgw[k * 8 + (lane & 7)]; }
        el += reb[lane]; gl += rgb[lane & 7];
        float best = -INFINITY; int bi = 0;
#pragma unroll
        for (int j = 0; j < 8; ++j) { const float vj = __shfl(gl, j); if (vj > best) { best = vj; bi = j; } }
        float gs = 0.f;
#pragma unroll
        for (int j = 0; j < 8; ++j) gs += __expf(__shfl(gl, j) - best);
        const float ggate = 1.f / gs;
        float t1 = -INFINITY, t2 = -INFINITY; int i1 = 0, i2 = 0;
#pragma unroll
        for (int j = 0; j < 8; ++j) { const float vj = __shfl(el, bi * 8 + j); if (vj > t1) { t2 = t1; i2 = i1; t1 = vj; i1 = j; } else if (vj > t2) { t2 = vj; i2 = j; } }
        const float p1 = 1.f / (1.f + __expf(t2 - t1)), p2 = 1.f - p1;
        if (lane == 0) {
            const int s0 = bi * 8 + i1, s1 = 64 + bi * 8 + i2;
            EID[m * 2] = s0; EID[m * 2 + 1] = s1; GATE[m * 2] = ggate * p1; GATE[m * 2 + 1] = ggate * p2;
            RANK[m * 2] = atomicAdd(&CNT[s0], 1); RANK[m * 2 + 1] = atomicAdd(&CNT[s1], 1);
        }
    }
}

constexpr int RT = 256;
__device__ __forceinline__ int seg_table(const CParams& p, int* offs, int* cnts) {
    const int* CNT = (const int*)(p.ws + WS_CTL) + CW_CNT;
    __syncthreads();
    if (threadIdx.x < NSEG) cnts[threadIdx.x] = __hip_atomic_load(CNT + threadIdx.x, __ATOMIC_RELAXED, __HIP_MEMORY_SCOPE_AGENT);
    __syncthreads();
    if (threadIdx.x == 0) { int run = 0; for (int s = 0; s < NSEG; ++s) { offs[s] = run; run += (cnts[s] + RT - 1) / RT; } offs[NSEG] = run; }
    __syncthreads();
    return offs[NSEG];
}
__device__ __forceinline__ int seg_of_tile(const int* offs, int rt) { int s = 0; for (int k = 64; k > 0; k >>= 1) if (offs[s + k] <= rt) s += k; return s; }

__device__ __forceinline__ void ph10_lists(const CParams& p, float* lds) {
    int* offs = (int*)lds; int* cnts = offs + 160;
    seg_table(p, offs, cnts);
    const int* EID = (const int*)(p.ws + WS_EID); const float* GATE = (const float*)(p.ws + WS_GATE); const int* RANK = (const int*)(p.ws + WS_RANK);
    int* LIST = (int*)(p.ws + WS_LIST); float* LG = (float*)(p.ws + WS_LG);
    for (int a = blockIdx.x * NTHREADS + threadIdx.x; a < M * 2; a += gridDim.x * NTHREADS) {
        const int s = EID[a], pos = offs[s] * RT + RANK[a];
        LIST[pos] = a >> 1; LG[pos] = GATE[a];
    }
}

__device__ __forceinline__ void convert_experts(const CParams& p, LAS unsigned char* ldsb) {
    const int lane = threadIdx.x & 63, wave = __builtin_amdgcn_readfirstlane(threadIdx.x >> 6);
    LAS float* scr = (LAS float*)(ldsb + wave * 8704);
    const int gw = blockIdx.x * NWAVES + wave, NGW = gridDim.x * NWAVES;
    bf16* EWGU = (bf16*)(p.ws + WS_EWGU); bf16* EWD = (bf16*)(p.ws + WS_EWD);
    for (int it = gw; it < NEXP * 768; it += NGW) {
        const int e = it / 768, r = it % 768, which = r >> 8, q = r & 255;
        if (which < 2) { const int kb = q >> 4, nb = q & 15, n0 = nb * 32;
            transpose_item(p.in[23 + which] + (size_t)e * DM * DEXP, DEXP, DM, EWGU + (size_t)e * 1024 * 1024, 256 * (n0 >> 7) + (n0 & 127) + 128 * which, kb * 64, n0, scr, lane); }
        else { const int kb = q >> 5, nb = q & 31;
            transpose_item(p.in[25] + (size_t)e * DEXP * DM, DM, DEXP, EWD + (size_t)e * 1024 * 512, nb * 32, kb * 64, nb * 32, scr, lane); }
    }
}

__device__ __forceinline__ int seg_of_tile_l(const LAS int* offs, int rt) { int s = 0;
#pragma unroll
    for (int k = 64; k > 0; k >>= 1) if (offs[s + k] <= rt) s += k; return s; }
struct GroupedOrder {
    const LAS int* offs; const LAS int* cnts; int G, c, K, t_lo, t_hi;
    __device__ __forceinline__ bool next(int i, pg8::Unit& u) const {
        const int L = i * G + c; if (L >= (t_hi - t_lo) * 4) return false;
        const int Lg = L + 4 * t_lo, s = seg_of_tile_l(offs, Lg >> 2), o = offs[s], Ts = offs[s + 1] - o, idx = Lg - 4 * o, pn = idx / Ts, rt = o + idx % Ts;
        u.pm = __builtin_amdgcn_readfirstlane(rt); u.pn = __builtin_amdgcn_readfirstlane(pn); u.arow = u.pm * 256; u.seg = __builtin_amdgcn_readfirstlane(s);
        int nv = cnts[s] - (rt - o) * 256; nv = nv > 256 ? 256 : nv; u.nvalid = __builtin_amdgcn_readfirstlane(nv);
        pg8::set_boff(u, ((size_t)(u.seg & 63) * 1024 + (size_t)u.pn * 256) * (size_t)K * 2);
        return true;
    }
};
__device__ __forceinline__ void seg_table_l(const CParams& p, LAS int* offs, LAS int* cnts) {
    const int* CNT = (const int*)(p.ws + WS_CTL) + CW_CNT;
    __syncthreads();
    if (threadIdx.x < NSEG) cnts[threadIdx.x] = __hip_atomic_load(CNT + threadIdx.x, __ATOMIC_RELAXED, __HIP_MEMORY_SCOPE_AGENT);
    __syncthreads();
    if (threadIdx.x == 0) { int run = 0; for (int s = 0; s < NSEG; ++s) { offs[s] = run; run += (cnts[s] + RT - 1) / RT; } offs[NSEG] = run; }
    __syncthreads();
}

struct EpiGateUp {
    static constexpr bool PERM = true;
    bf16* HID;
    __device__ __forceinline__ void operator()(const f32x4 (&acc)[2][2][4][2], const pg8::Unit& u, int wr, int wc, int fr, int fq, LAS unsigned char* lds) const {
#pragma unroll
        for (int ai = 0; ai < 2; ++ai)
#pragma unroll
            for (int m = 0; m < 4; ++m) { float hv[8];
#pragma unroll
                for (int n = 0; n < 2; ++n)
#pragma unroll
                    for (int i = 0; i < 4; ++i) { const float g = acc[ai][0][m][n][i]; hv[n * 4 + i] = g * acc[ai][1][m][n][i] * __builtin_amdgcn_rcpf(1.f + __expf(-g)); }
                *(u32x4*)(HID + (size_t)(u.arow + ai * 128 + wr * 64 + m * 16 + fr) * DEXP + u.pn * 128 + wc * 32 + 8 * fq) =
                    (u32x4){pg8::cvt_pk_bf16(hv[0], hv[1]), pg8::cvt_pk_bf16(hv[2], hv[3]), pg8::cvt_pk_bf16(hv[4], hv[5]), pg8::cvt_pk_bf16(hv[6], hv[7])}; }
    }
};
__device__ __forceinline__ void ph11_gateup(const CParams& p, LAS unsigned char* ldsb) {
    LAS int* offs = (LAS int*)(ldsb + 139264); LAS int* cnts = offs + 160;
    seg_table_l(p, offs, cnts);
    GroupedOrder S{offs, cnts, (int)gridDim.x, (int)((blockIdx.x % 8) * (gridDim.x / 8) + blockIdx.x / 8), DM, 0, offs[NSEG]};
    EpiGateUp E{(bf16*)(p.ws + WS_HID)};
    pg8::gemm_phase<EpiGateUp, GroupedOrder, true, true>(ldsb, (const bf16*)(p.ws + WS_H2), (const bf16*)(p.ws + WS_EWGU), DM, (const int*)(p.ws + WS_LIST), S, E);
}

struct EpiDown {
    static constexpr bool PERM = false;
    float* out; const int* LIST; const float* LG;
    __device__ __forceinline__ void operator()(const f32x4 (&acc)[2][2][4][2], const pg8::Unit& u, int wr, int wc, int fr, int fq, LAS unsigned char* lds) const {
        const int col0 = u.pn * 256 + wc * 32 + 4 * fq;
#pragma unroll
        for (int ai = 0; ai < 2; ++ai)
#pragma unroll
            for (int m = 0; m < 4; ++m) { const int rl = ai * 128 + wr * 64 + m * 16 + fr;
                if (rl < u.nvalid) { const int tok = LIST[u.arow + rl]; const float g = LG[u.arow + rl]; float* o = out + (size_t)tok * DM + col0;
#pragma unroll
                    for (int bj = 0; bj < 2; ++bj)
#pragma unroll
                        for (int n = 0; n < 2; ++n) { const f32x4 xv = *(const f32x4*)(o + bj * 128 + n * 16); *(f32x4*)(o + bj * 128 + n * 16) = xv + acc[ai][bj][m][n] * g; } } }
    }
};
__device__ __forceinline__ void ph12_down(const CParams& p, LAS unsigned char* ldsb, int pass) {
    LAS int* offs = (LAS int*)(ldsb + 139264); LAS int* cnts = offs + 160;
    seg_table_l(p, offs, cnts);
    GroupedOrder S{offs, cnts, (int)gridDim.x, (int)((blockIdx.x % 8) * (gridDim.x / 8) + blockIdx.x / 8), DEXP, offs[64 * pass], offs[64 * pass + 64]};
    EpiDown E{p.out, (const int*)(p.ws + WS_LIST), (const float*)(p.ws + WS_LG)};
    pg8::gemm_phase<EpiDown, GroupedOrder, true, false>(ldsb, (const bf16*)(p.ws + WS_HID), (const bf16*)(p.ws + WS_EWD), DEXP, nullptr, S, E);
}

__global__ void __launch_bounds__(NTHREADS, 2) fwd_kernel(Params p_unused) {
    extern __shared__ __attribute__((aligned(16))) unsigned char lds_raw[];
    float* lds = (float*)lds_raw;
    const CParams* kp = (const CParams*)__builtin_amdgcn_kernarg_segment_ptr();
#define P (*kp_launder(kp))
    volatile LAS unsigned* MISC = (volatile LAS unsigned*)((LAS unsigned char*)lds_raw + LDS_BYTES - 256);
    if (threadIdx.x < 64) MISC[threadIdx.x] = 0u;
    __syncthreads();
    XcdBarrier bar; bar.bar = (unsigned*)(kp->ws + WS_CTL) + CW_BAR; bar.x = 0; bar.st = nullptr;
    if (N_LAUNCHES == 1) bar = xcd_barrier_post((unsigned*)(kp->ws + WS_CTL) + CW_BAR, MISC + 8);
    const int lo = kp->ph_lo, hi = kp->ph_hi;
#ifdef ONLY_PHASE
#define IN(k) ((k) == ONLY_PHASE && lo <= (k) && (k) < hi)
#elif defined(PHASE_MASK)
#define IN(k) (((PHASE_MASK >> (k)) & 1) && lo <= (k) && (k) < hi)
#else
#define IN(k) (lo <= (k) && (k) < hi)
#endif
#define SEAM(k) do { if (IN(k) && IN((k) + 1)) xcd_barrier(bar); } while (0)
    LAS unsigned char* ldsb = (LAS unsigned char*)lds_raw;
    if (IN(0)) ph0_prologue(P, ldsb);
    SEAM(0);
    if (IN(1)) ph1_win(P, ldsb);
    SEAM(1);
    if (IN(2)) ph3_cumsum(P, lds);
    SEAM(2);
    if (IN(3)) ph4_attn_mfma(P, ldsb);
    SEAM(3);
    if (IN(4)) rw_b1_fast(P, ldsb);
    SEAM(4);
    if (IN(5)) rw_b2_fast(P);
    SEAM(5);
    if (IN(6)) rw_b3_fast(P);
    SEAM(6);
    if (IN(7)) { ph8_wout(P, ldsb); convert_experts(P, ldsb); }
    SEAM(7);
    if (IN(8)) ph9_route(P, lds);
    SEAM(8);
    if (IN(9)) ph10_lists(P, lds);
    SEAM(9);
    if (IN(10)) ph11_gateup(P, ldsb);
    SEAM(10);
    if (IN(11)) ph12_down(P, ldsb, 0);
    SEAM(11);
    if (IN(12)) ph12_down(P, ldsb, 1);
#undef IN
#undef SEAM
#undef P
}

extern "C" void kernel_launch(void* const* d_in, const int* in_sizes, int n_in, void* d_out, int out_size, void* d_ws, size_t ws_size, hipStream_t stream) {
    static int grid = 0;
    if (grid == 0) {
        if (n_in != 26 || in_sizes[0] != M * DM || out_size != M * DM || ws_size < WS_END) { fprintf(stderr, "kernel_launch: unexpected shapes / workspace (n_in %d, ws %zu)\n", n_in, ws_size); grid = -1; return; }
        int dev = 0, cus = 0, per_cu = 0;
        if (hipGetDevice(&dev) != hipSuccess || hipDeviceGetAttribute(&cus, hipDeviceAttributeMultiprocessorCount, dev) != hipSuccess) { grid = -1; return; }
        if (hipFuncSetAttribute((const void*)fwd_kernel, hipFuncAttributeMaxDynamicSharedMemorySize, LDS_BYTES) != hipSuccess) { fprintf(stderr, "kernel_launch: hipFuncSetAttribute failed\n"); grid = -1; return; }
        if (hipOccupancyMaxActiveBlocksPerMultiprocessor(&per_cu, (const void*)fwd_kernel, NTHREADS, LDS_BYTES) != hipSuccess || per_cu < 1) { fprintf(stderr, "kernel_launch: occupancy query failed (%d)\n", per_cu); (void)hipGetLastError(); per_cu = 1; }
        grid = cus * per_cu;
    }
    if (grid < 0) return;
    (void)hipMemsetAsync((char*)d_ws + WS_CTL, 0, CTL_ZERO_BYTES, stream);
    Params a{};
    for (int i = 0; i < 26; ++i) a.in[i] = (const float*)d_in[i];
    a.out = (float*)d_out; a.ws = (unsigned char*)d_ws;
    if (N_LAUNCHES == 1) {
        a.ph_lo = 0; a.ph_hi = NPHASE; a.li = 0;
        void* args[] = {&a};
        hipError_t e = hipLaunchCooperativeKernel((const void*)fwd_kernel, dim3(grid), dim3(NTHREADS), args, LDS_BYTES, stream);
        if (e != hipSuccess) fprintf(stderr, "kernel_launch: cooperative launch failed: %s (grid %d)\n", hipGetErrorString(e), grid);
    } else {
        for (int li = 0; li < NPHASE; ++li) {
            a.ph_lo = li; a.ph_hi = li + 1; a.li = li;
            hipLaunchKernelGGL(fwd_kernel, dim3(grid), dim3(NTHREADS), LDS_BYTES, stream, a);
        }
    }
}
```
